# Optimizing an MI355X kernel written in HIP

```python
import math
import jax
import jax.numpy as jnp
from jax import lax
import numpy as np

D_MODEL = 2048
BATCH = 4
SEQ = 4096
DEPTH = 1

GRID_W = 64
CTX_LEN = 256
RW_HEADS = 16
HEAD_DIM = 64
RW_DIM = RW_HEADS * HEAD_DIM
DECAY_LORA = 64
ICLR_LORA = 64
GATE_LORA = 160
RW_COLS = 3 * RW_DIM + DECAY_LORA + ICLR_LORA + GATE_LORA
HY_DIM = D_MODEL - RW_DIM
HY_COLS = 3 * HY_DIM
IN_COLS = RW_COLS + HY_COLS
FILTER_WIDTH = 64
N_BANDS = 16
POS_EMB_DIM = 1 + 2 * N_BANDS
DECAY_TARGET = 1e-2
FAST_DECAY_PCT = 0.3
SLOW_DECAY_PCT = 1.5
D_FF = -(-8 * D_MODEL // (3 * 256)) * 256
ALPHA = (2 * DEPTH) ** 0.25
BETA = (8 * DEPTH) ** -0.25
LN_EPS = 1e-5
GN_EPS = 64e-5

kernel_name = 'hybrid_rwkv7_hyena_dit_block'


def layer_norm(h, g, b):
    hf = h.astype(jnp.float32)
    mu = jnp.mean(hf, -1, keepdims=True)
    var = jnp.mean(jnp.square(hf - mu), -1, keepdims=True)
    return ((hf - mu) * lax.rsqrt(var + LN_EPS) * g + b).astype(h.dtype)


def modulate(h, shift, scale):
    return h * (1 + scale) + shift


def conv3(h, w):
    hp = jnp.pad(h, ((0, 0), (1, 1), (0, 0)))
    return hp[:, :-2] * w[0] + hp[:, 1:-1] * w[1] + hp[:, 2:] * w[2]


def grid_pos_embed(rows):
    quarter = D_MODEL // 4
    half = D_MODEL // 2
    omega = 1.0 / (10000.0 ** (jnp.arange(quarter, dtype=jnp.float32) / quarter))
    er = jnp.arange(rows, dtype=jnp.float32)[:, None] * omega
    ec = jnp.arange(GRID_W, dtype=jnp.float32)[:, None] * omega
    er = jnp.concatenate([jnp.sin(er), jnp.cos(er)], -1)
    ec = jnp.concatenate([jnp.sin(ec), jnp.cos(ec)], -1)
    emb = jnp.concatenate([jnp.broadcast_to(er[:, None, :], (rows, GRID_W, half)),
                           jnp.broadcast_to(ec[None, :, :], (rows, GRID_W, half))], -1)
    return emb.reshape(rows * GRID_W, D_MODEL)


def rwkv7_scan(S0, r, w, k, v, a, b, reverse):
    def step(S, inp):
        rt, wt, kt, vt, at, bt = inp
        sa = jnp.einsum('bhij,bhj->bhi', S, at)
        S = S * wt[:, :, None, :] + sa[..., None] * bt[:, :, None, :] + vt[..., None] * kt[:, :, None, :]
        return S, jnp.einsum('bhij,bhj->bhi', S, rt)
    xs = tuple(jnp.swapaxes(t, 0, 1) for t in (r, w, k, v, a, b))
    S, ys = lax.scan(step, S0, xs, reverse=reverse)
    return S, jnp.swapaxes(ys, 0, 1)


def head_group_norm(y, g, b):
    mu = jnp.mean(y, -1, keepdims=True)
    var = jnp.mean(jnp.square(y - mu), -1, keepdims=True)
    return (y - mu) * lax.rsqrt(var + GN_EPS) * g.reshape(RW_HEADS, HEAD_DIM) + b.reshape(RW_HEADS, HEAD_DIM)


def rwkv7_time_mix(rw, S0_f, S0_b, w0_f, w_up_f, a0_f, a_up_f, w0_b, w_up_b, a0_b, a_up_b,
                   k_k, k_a, r_k, g_up, gn_g, gn_b):
    dt = rw.dtype
    rw = rw.astype(jnp.float32)
    B, L, _ = rw.shape
    heads = lambda t: t.reshape(B, L, RW_HEADS, HEAD_DIM)
    cuts = [RW_DIM, 2 * RW_DIM, 3 * RW_DIM, 3 * RW_DIM + DECAY_LORA, 3 * RW_DIM + DECAY_LORA + ICLR_LORA]
    r, k, v, w_lo, a_lo, g_lo = jnp.split(rw, cuts, axis=-1)
    kk = heads(k * k_k)
    kk = kk / jnp.maximum(jnp.linalg.norm(kk, axis=-1, keepdims=True), 1e-12)
    gate = jax.nn.sigmoid(g_lo) @ g_up
    tw = jnp.tanh(w_lo)
    rh, vh = heads(r), heads(v)
    outs, states = [], []
    for w0, w_up, a0, a_up, S0, rev in ((w0_f, w_up_f, a0_f, a_up_f, S0_f, False),
                                       (w0_b, w_up_b, a0_b, a_up_b, S0_b, True)):
        log_w = -jax.nn.softplus(-(w0 + tw @ w_up)) - 0.5
        decay = jnp.exp(-jnp.exp(log_w))
        a = jax.nn.sigmoid(a0 + a_lo @ a_up)
        kh = heads(k * (1 + (a - 1) * k_a))
        S, y = rwkv7_scan(S0, rh, heads(decay), kh, vh, -kk, kk * heads(a), rev)
        bonus = jnp.sum(rh * kh * r_k.reshape(RW_HEADS, HEAD_DIM), -1, keepdims=True) * vh
        outs.append(head_group_norm(y, gn_g, gn_b) + bonus)
        states.append(S)
    o = (outs[0] + outs[1]).reshape(B, L, RW_DIM) * gate
    return o.astype(dt), states[0], states[1]


def two_sided_filter(L, filt_w1, filt_b1, filt_w2, filt_b2, filt_w3, sin_freq):
    pos = jnp.arange(L, dtype=jnp.float32)[:, None]
    t = jnp.linspace(0.0, 1.0, L, dtype=jnp.float32)[:, None]
    bands = jnp.linspace(1e-4, N_BANDS - 1, N_BANDS, dtype=jnp.float32)[None, :]
    ang = 2.0 * math.pi * bands * pos / L
    z = jnp.concatenate([t, jnp.cos(ang), -jnp.sin(ang)], -1)
    h = jnp.sin(sin_freq * (z @ filt_w1 + filt_b1))
    h = jnp.sin(sin_freq * (h @ filt_w2 + filt_b2))
    h = h @ filt_w3
    max_decay = math.log(DECAY_TARGET) / FAST_DECAY_PCT
    min_decay = math.log(DECAY_TARGET) / SLOW_DECAY_PCT
    deltas = jnp.abs(jnp.linspace(min_decay, max_decay, HY_DIM, dtype=jnp.float32))
    window = jnp.exp(-t * deltas)
    h_f = h[:, :HY_DIM] * window
    h_b = h[:, HY_DIM:] * window
    return jnp.concatenate([h_f, jnp.zeros((1, HY_DIM), h_f.dtype), h_b[:0:-1]], 0)


def fft_long_conv(u, kern):
    L = u.shape[1]
    n = 2 * L
    uf = jnp.fft.rfft(u, n=n, axis=1)
    kf = jnp.fft.rfft(kern, n=n, axis=0)
    return jnp.fft.irfft(uf * kf[None], n=n, axis=1)[:, :L]


def hyena_mix(hy, conv_w, conv_b, filt_w1, filt_b1, filt_w2, filt_b2, filt_w3, sin_freq, bias):
    dt = hy.dtype
    hy = (conv3(hy, conv_w) + conv_b).astype(jnp.float32)
    x0, x1, v = jnp.split(hy, 3, axis=-1)
    kern = two_sided_filter(hy.shape[1], filt_w1, filt_b1, filt_w2, filt_b2, filt_w3, sin_freq)
    z = v * x1
    z = fft_long_conv(z, kern) + z * bias
    return (z * x0).astype(dt)


def swiglu(u, w1, w3, w2):
    return (jax.nn.silu(u @ w1) * (u @ w3)) @ w2


def setup_inputs(seed: int = 0) -> dict:
    key = jax.random.key(seed)
    ks = iter(jax.random.split(key, 48))

    def nrm(shape, scale):
        return jax.random.normal(next(ks), shape, jnp.float32) * scale

    def gain(shape):
        return 1.0 + nrm(shape, 0.02)

    Dm = D_MODEL
    centre = jnp.array([0.0, 1.0, 0.0], jnp.float32)[None, :, None]
    return {
        'x': nrm((BATCH, SEQ, Dm), 1.0),
        'c': nrm((BATCH, Dm), 1.0),
        'ctx': nrm((BATCH, CTX_LEN, Dm), 1.0),
        'c_ctx': nrm((Dm,), 1.0),
        'w_ada': nrm((DEPTH, Dm, 6 * Dm), Dm ** -0.5),
        'b_ada': nrm((DEPTH, 6 * Dm), 0.02),
        'w_in': nrm((DEPTH, Dm, IN_COLS), Dm ** -0.5),
        'conv_rw': centre + nrm((DEPTH, 3, RW_COLS), 0.3),
        'conv_hy': nrm((DEPTH, 3, HY_COLS), 3 ** -0.5),
        'conv_hy_b': nrm((DEPTH, HY_COLS), 0.02),
        'w0_f': nrm((DEPTH, RW_DIM), 0.5),
        'w_up_f': nrm((DEPTH, DECAY_LORA, RW_DIM), 0.5 * DECAY_LORA ** -0.5),
        'a0_f': nrm((DEPTH, RW_DIM), 0.5),
        'a_up_f': nrm((DEPTH, ICLR_LORA, RW_DIM), 0.5 * ICLR_LORA ** -0.5),
        'w0_b': nrm((DEPTH, RW_DIM), 0.5),
        'w_up_b': nrm((DEPTH, DECAY_LORA, RW_DIM), 0.5 * DECAY_LORA ** -0.5),
        'a0_b': nrm((DEPTH, RW_DIM), 0.5),
        'a_up_b': nrm((DEPTH, ICLR_LORA, RW_DIM), 0.5 * ICLR_LORA ** -0.5),
        'k_k': 0.85 + nrm((DEPTH, RW_DIM), 0.02),
        'k_a': gain((DEPTH, RW_DIM)),
        'r_k': nrm((DEPTH, RW_DIM), 0.1),
        'g_up': nrm((DEPTH, GATE_LORA, RW_DIM), GATE_LORA ** -0.5),
        'gn_g': gain((DEPTH, RW_DIM)),
        'gn_b': nrm((DEPTH, RW_DIM), 0.02),
        'filt_w1': nrm((DEPTH, POS_EMB_DIM, FILTER_WIDTH), POS_EMB_DIM ** -0.5),
        'filt_b1': nrm((DEPTH, FILTER_WIDTH), 0.02),
        'filt_w2': nrm((DEPTH, FILTER_WIDTH, FILTER_WIDTH), FILTER_WIDTH ** -0.5),
        'filt_b2': nrm((DEPTH, FILTER_WIDTH), 0.02),
        'filt_w3': nrm((DEPTH, FILTER_WIDTH, 2 * HY_DIM), 0.02 * FILTER_WIDTH ** -0.5),
        'sin_freq': gain((DEPTH, FILTER_WIDTH)),
        'hy_bias': nrm((DEPTH, HY_DIM), 0.5),
        'w_out': nrm((DEPTH, Dm, Dm), BETA * Dm ** -0.5),
        'ln1_g': gain((DEPTH, Dm)),
        'ln1_b': nrm((DEPTH, Dm), 0.02),
        'ffn_w1': nrm((DEPTH, Dm, D_FF), BETA * Dm ** -0.5),
        'ffn_w3': nrm((DEPTH, Dm, D_FF), BETA * Dm ** -0.5),
        'ffn_w2': nrm((DEPTH, D_FF, Dm), BETA * D_FF ** -0.5),
        'ln2_g': gain((DEPTH, Dm)),
        'ln2_b': nrm((DEPTH, Dm), 0.02),
    }


def reference(x, c, ctx, c_ctx, w_ada, b_ada, w_in, conv_rw, conv_hy, conv_hy_b,
              w0_f, w_up_f, a0_f, a_up_f, w0_b, w_up_b, a0_b, a_up_b,
              k_k, k_a, r_k, g_up, gn_g, gn_b,
              filt_w1, filt_b1, filt_w2, filt_b2, filt_w3, sin_freq, hy_bias,
              w_out, ln1_g, ln1_b, ffn_w1, ffn_w3, ffn_w2, ln2_g, ln2_b):
    B, L, _ = x.shape
    ROWS = L // GRID_W
    x = x + grid_pos_embed(ROWS).astype(x.dtype)[None]
    h_ctx = ctx
    zero_state = jnp.zeros((B, RW_HEADS, HEAD_DIM, HEAD_DIM), jnp.float32)
    for l in range(DEPTH):
        last = l == DEPTH - 1
        mod = jax.nn.silu(c) @ w_ada[l] + b_ada[l]
        mod_c = jax.nn.silu(c_ctx) @ w_ada[l] + b_ada[l]
        sh1, sc1, g1, sh2, sc2, g2 = jnp.split(mod[:, None, :], 6, axis=-1)
        csh1, csc1, cg1, csh2, csc2, cg2 = jnp.split(mod_c, 6)
        rw_p = dict(w0_f=w0_f[l], w_up_f=w_up_f[l], a0_f=a0_f[l], a_up_f=a_up_f[l],
                    w0_b=w0_b[l], w_up_b=w_up_b[l], a0_b=a0_b[l], a_up_b=a_up_b[l],
                    k_k=k_k[l], k_a=k_a[l], r_k=r_k[l], g_up=g_up[l], gn_g=gn_g[l], gn_b=gn_b[l])
        hy_p = dict(conv_w=conv_hy[l], conv_b=conv_hy_b[l], filt_w1=filt_w1[l], filt_b1=filt_b1[l],
                    filt_w2=filt_w2[l], filt_b2=filt_b2[l], filt_w3=filt_w3[l], sin_freq=sin_freq[l],
                    bias=hy_bias[l])
        proj = modulate(x, sh1, sc1) @ w_in[l]
        proj_c = modulate(h_ctx, csh1, csc1) @ w_in[l]
        o_rw_c, S_f, S_b = rwkv7_time_mix(conv3(proj_c[..., :RW_COLS], conv_rw[l]), zero_state, zero_state, **rw_p)
        o_rw, _, _ = rwkv7_time_mix(conv3(proj[..., :RW_COLS], conv_rw[l]), S_f, S_b, **rw_p)
        o_hy = hyena_mix(proj[..., RW_COLS:], **hy_p)
        mix = jnp.concatenate([o_rw, o_hy], -1) @ w_out[l]
        x = layer_norm(ALPHA * x + g1 * mix, ln1_g[l], ln1_b[l])
        ff = swiglu(modulate(x, sh2, sc2), ffn_w1[l], ffn_w3[l], ffn_w2[l])
        x = layer_norm(ALPHA * x + g2 * ff, ln2_g[l], ln2_b[l])
        if not last:
            o_hy_c = hyena_mix(proj_c[..., RW_COLS:], **hy_p)
            mix_c = jnp.concatenate([o_rw_c, o_hy_c], -1) @ w_out[l]
            h_ctx = layer_norm(ALPHA * h_ctx + cg1 * mix_c, ln1_g[l], ln1_b[l])
            ff_c = swiglu(modulate(h_ctx, csh2, csc2), ffn_w1[l], ffn_w3[l], ffn_w2[l])
            h_ctx = layer_norm(ALPHA * h_ctx + cg2 * ff_c, ln2_g[l], ln2_b[l])
    return x
```

```cpp
#include <hip/hip_runtime.h>
#include <hip/hip_cooperative_groups.h>
#include <cstdio>
#include <cstdint>
namespace cg = cooperative_groups;

#define LAS __attribute__((address_space(3)))
typedef unsigned short bf16_t;
typedef short bf16x8 __attribute__((ext_vector_type(8)));
typedef float f32x4 __attribute__((ext_vector_type(4)));
typedef float f32x2 __attribute__((ext_vector_type(2)));
typedef unsigned u32x4 __attribute__((ext_vector_type(4)));
typedef unsigned u32x2 __attribute__((ext_vector_type(2)));
typedef _Float16 h16;
typedef _Float16 h16x8 __attribute__((ext_vector_type(8)));

constexpr int D = 2048, NB = 4, SEQ = 4096, NTOK = NB * SEQ, CTX = 256, NCTX = NB * CTX, MROWS = NTOK + NCTX;
constexpr int RW = 1024, RW_COLS = 3360, RWP = 3584, HY = 1024, NP = 6656, IN_COLS = 6432, DFF = 5632;
constexpr int KL = 384, NL = 5120;
constexpr float ALPHA = 1.189207115f;
constexpr float LN_EPS = 1e-5f, GN_EPS = 64e-5f;
constexpr size_t MBy = 1u << 20;
constexpr size_t OFF_MOD = 0, OFF_MODP = 256 * 1024, OFF_PE = OFF_MODP + 7680 * 1024, OFF_H2 = 8 * MBy, OFF_LB = 9 * MBy, OFF_BAR = 9 * MBy + 512 * 1024, OFF_WOUT = 10 * MBy, OFF_BT2 = 18 * MBy,
                 OFF_R1 = 22 * MBy, OFF_R6 = 48 * MBy, OFF_R4 = 216 * MBy, OFF_R5 = 284 * MBy, WS_END = 505 * MBy;
constexpr size_t LORA_STRIDE = (size_t)MROWS * 1024;
constexpr int LDS_BYTES = 131072 + 16;
constexpr int NTHREADS = 512;

struct Params { const float* in[39]; float* out; unsigned char* ws; int ph_lo, ph_hi; };

enum { I_X = 0, I_C, I_CTX, I_CCTX, I_WADA, I_BADA, I_WIN, I_CONVRW, I_CONVHY, I_CONVHYB, I_W0F, I_WUPF, I_A0F, I_AUPF, I_W0B, I_WUPB, I_A0B, I_AUPB,
       I_KK, I_KA, I_RK, I_GUP, I_GNG, I_GNB, I_FW1, I_FB1, I_FW2, I_FB2, I_FW3, I_SINF, I_HYB, I_WOUT, I_LN1G, I_LN1B, I_FFW1, I_FFW3, I_FFW2, I_LN2G, I_LN2B };

__device__ __forceinline__ unsigned cvt_pk_bf16(float lo, float hi) { unsigned r; asm volatile("v_cvt_pk_bf16_f32 %0, %1, %2" : "=v"(r) : "v"(lo), "v"(hi)); return r; }
__device__ __forceinline__ float bf2f(unsigned short v) { return __uint_as_float(((unsigned)v) << 16); }
__device__ __forceinline__ float sigmoidf_(float x) { return __builtin_amdgcn_rcpf(1.0f + __expf(-x)); }
__device__ __forceinline__ float wave_sum(float v) {
#pragma unroll
    for (int o = 32; o >= 1; o >>= 1) v += __shfl_xor(v, o);
    return v;
}
template <int CTRL> __device__ __forceinline__ float dpp_f(float v) { return __int_as_float(__builtin_amdgcn_update_dpp(0, __float_as_int(v), CTRL, 0xf, 0xf, true)); }
__device__ __forceinline__ float sum16(float v) { v += dpp_f<0xB1>(v); v += dpp_f<0x4E>(v); v += dpp_f<0x141>(v); v += dpp_f<0x140>(v); return v; }
__device__ __forceinline__ float sum8(float v) { v += dpp_f<0xB1>(v); v += dpp_f<0x4E>(v); v += dpp_f<0x141>(v); return v; }


#define XB_TMO      128
#define XB_XCNT(j)  (256  + 64 * (j))
#define XB_XSUB(j)  (1280 + 64 * (j))
#define XB_XGEN(j)  (2304 + 64 * (j))
#define XB_TOP      3328
#define XB_TOPGEN   3392
#define XCD_BAR_WORDS 3456
#define XB_SPIN_CAP (1u << 18)
__device__ __forceinline__ unsigned xb_ld(unsigned* p)              { return __hip_atomic_load(p, __ATOMIC_RELAXED, __HIP_MEMORY_SCOPE_AGENT); }
__device__ __forceinline__ unsigned xb_add(unsigned* p, unsigned v) { return __hip_atomic_fetch_add(p, v, __ATOMIC_RELAXED, __HIP_MEMORY_SCOPE_AGENT); }
__device__ __forceinline__ unsigned xb_xcc_id() { return (unsigned)__builtin_amdgcn_s_getreg((3 << 11) | 20) & 0xFu; }
#define XB_SPIN(cond, bar) do { unsigned _sp = 0; while (cond) { __builtin_amdgcn_s_sleep(1); \
    if ((++_sp & 255u) == 0u) { if (xb_ld(&(bar)[XB_TMO])) break; if (_sp > XB_SPIN_CAP) { atomicAdd(&(bar)[XB_TMO], 1u); break; } } } } while (0)
struct XcdBarrier { unsigned* bar; unsigned x; volatile LAS unsigned* st; };
__device__ __forceinline__ XcdBarrier xcd_barrier_post(unsigned* bar, volatile LAS unsigned* st) {
    XcdBarrier b; b.bar = bar; b.x = xb_xcc_id(); b.st = st;
    if (threadIdx.x == 0) (void)xb_add(&bar[XB_XCNT(b.x)], 1u);
    return b;
}
__device__ __forceinline__ void xcd_barrier_complete(unsigned* bar, unsigned x, unsigned& nloc, unsigned& nx) {
    const unsigned G = gridDim.x * gridDim.y * gridDim.z;
    unsigned sum, cnt, mine, sp = 0u;
    for (;;) {
        sum = 0u; cnt = 0u; mine = 0u;
#pragma unroll
        for (unsigned j = 0; j < 16; ++j) { const unsigned c = xb_ld(&bar[XB_XCNT(j)]); sum += c; cnt += (c > 0u) ? 1u : 0u; mine = (j == x) ? c : mine; }
        if (sum == G) break;
        __builtin_amdgcn_s_sleep(1);
        if ((++sp & 255u) == 0u) { if (xb_ld(&bar[XB_TMO])) break; if (sp > XB_SPIN_CAP) { atomicAdd(&bar[XB_TMO], 1u); break; } }
    }
    nloc = mine > 0u ? mine : 1u; nx = cnt > 0u ? cnt : 1u;
}
__device__ __forceinline__ void xcd_barrier(const XcdBarrier& b) {
    asm volatile("s_waitcnt vmcnt(0)" ::: "memory");
    __syncthreads();
    if (threadIdx.x == 0) {
        unsigned* bar = b.bar;
        __builtin_amdgcn_s_waitcnt(0);
        unsigned nloc = b.st[0], nx = b.st[1];
        if (nloc == 0u) { xcd_barrier_complete(bar, b.x, nloc, nx); b.st[0] = nloc; b.st[1] = nx; }
        const unsigned old = xb_add(&bar[XB_XSUB(b.x)], 1u);
        const unsigned gen = old / nloc;
        if (old + 1u == (gen + 1u) * nloc) {
            __builtin_amdgcn_fence(__ATOMIC_RELEASE, "agent");
            asm volatile("s_waitcnt vmcnt(0)" ::: "memory");
            const unsigned og = xb_add(&bar[XB_TOP], 1u);
            const unsigned tg = og / nx;
            if (og + 1u == (tg + 1u) * nx) xb_add(&bar[XB_TOPGEN], 1u);
            else XB_SPIN(xb_ld(&bar[XB_TOPGEN]) == tg, bar);
            __builtin_amdgcn_fence(__ATOMIC_ACQUIRE, "agent");
            xb_add(&bar[XB_XGEN(b.x)], 1u);
            asm volatile("s_waitcnt vmcnt(0)" ::: "memory");
        } else {
            XB_SPIN(xb_ld(&bar[XB_XGEN(b.x)]) == gen, bar);
            __builtin_amdgcn_fence(__ATOMIC_ACQUIRE, "agent");
            asm volatile("s_waitcnt vmcnt(0)" ::: "memory");
        }
    }
    __syncthreads();
}

namespace pg8 {
constexpr int BM = 256, BK = 64, HALF = 128, HTB = HALF * BK * 2, STAGE_BYTES = 8 * HTB, NXCD = 8, WGM = 8;
__host__ __device__ __forceinline__ int lds_byte(int r, int c) { const int st = (r >> 4) * 2 + (c >> 5), rr = r & 15, cc = c & 31, ob = rr * 64 + cc * 2; return st * 1024 + (ob ^ (((ob >> 9) & 1) << 5)); }
__host__ __device__ __forceinline__ void stage_rc(int b, int& R, int& C) { const int st = b / 1024, sb = b % 1024, swz = sb ^ (((sb >> 9) & 1) << 5); R = (st >> 1) * 16 + swz / 64; C = (st & 1) * 32 + (swz % 64) / 2; }
__host__ __device__ __forceinline__ int perm32(int rho) { const int n = rho >> 4, i = rho & 15; return 8 * (i >> 2) + 4 * n + (i & 3); }
struct Unit { int pm, pn; };
struct Gemm { const bf16_t* A; const bf16_t* Bt; int M, N, K; };
struct StaticOrder {
    int nM, nN, nwg, G, c;
    __host__ __device__ void init(int M, int N, int G_, int c_) { nM = M / BM; nN = N / BM; nwg = nM * nN; G = G_; c = c_; }
    __host__ __device__ bool next(int i, Unit& u) const {
        const long L = (long)i * G + c; if (L >= nwg) return false;
        int wgid = (int)L; { const int q = nwg / NXCD, r = nwg % NXCD, xcd = wgid % NXCD, off = wgid / NXCD; wgid = (xcd < r ? xcd * (q + 1) : r * (q + 1) + (xcd - r) * q) + off; }
        const int nig = WGM * nN, gid = wgid / nig, fm = gid * WGM, gsz = (nM - fm) < WGM ? (nM - fm) : WGM;
        u.pm = fm + ((wgid % nig) % gsz); u.pn = (wgid % nig) / gsz; return true;
    }
    __device__ __forceinline__ void a_ready(const Unit&) const {}
    __device__ __forceinline__ void done(const Unit&) const {}
};

template <class Epi, class Sched>
__device__ __forceinline__ void gemm_phase(LAS unsigned char* lds, const Gemm g, const Sched& S, const Epi& E) {
    const int tid = threadIdx.x, wid = __builtin_amdgcn_readfirstlane(tid >> 6), lane = tid & 63, wr = wid >> 2, wc = wid & 3, fr = lane & 15, fq = lane >> 4;
    const int K = g.K, nt = K / BK;
    unsigned voffA[2], voffB[2];
#pragma unroll
    for (int i = 0; i < 2; ++i) { int R, C; stage_rc(tid * 16 + i * 8192, R, C); const int Rb = Epi::PERM ? ((R & ~31) + perm32(R & 31)) : R;
        voffA[i] = (unsigned)(R * K + C) * 2u; voffB[i] = (unsigned)(Rb * K + C) * 2u; }
    const size_t kstep = (size_t)(BK * 2);
    const size_t hstep = (size_t)HALF * K * 2;
    const size_t tstep = 2 * hstep;
    const unsigned ldsw = (unsigned)wid * 1024u;
    const int aoff = lds_byte(wr * 64 + fr, fq * 8), boff = lds_byte(wc * 32 + fr, fq * 8);
#define PG8_SA(b, h) (((b) * 2 + (h)) * HTB)
#define PG8_SB(b, h) ((4 + (b) * 2 + (h)) * HTB)
#define PG8_STAGE(bufoff, gbase, voff) do { _Pragma("unroll") for (int _i = 0; _i < 2; ++_i) \
        __builtin_amdgcn_global_load_lds((const unsigned*)((const char*)(gbase) + (voff)[_i]), (LAS unsigned*)(lds + (bufoff) + ldsw + _i * 8192), 16, 0, 0); } while (0)
#define PG8_LDA(dst, b, h) do { _Pragma("unroll") for (int m = 0; m < 4; ++m) _Pragma("unroll") for (int k = 0; k < 2; ++k) dst[m][k] = *(const LAS bf16x8*)(lds + PG8_SA(b, h) + aoff + m * 2048 + k * 1024); } while (0)
#define PG8_LDB(dst, b, h) do { _Pragma("unroll") for (int n = 0; n < 2; ++n) _Pragma("unroll") for (int k = 0; k < 2; ++k) dst[n][k] = *(const LAS bf16x8*)(lds + PG8_SB(b, h) + boff + n * 2048 + k * 1024); } while (0)
#define PG8_MMA(ai, bj, At, Bt) do { __builtin_amdgcn_s_setprio(1); _Pragma("unroll") for (int m = 0; m < 4; ++m) _Pragma("unroll") for (int n = 0; n < 2; ++n) _Pragma("unroll") for (int k = 0; k < 2; ++k) \
        acc[ai][bj][m][n] = __builtin_amdgcn_mfma_f32_16x16x32_bf16(Bt[n][k], At[m][k], acc[ai][bj][m][n], 0, 0, 0); __builtin_amdgcn_s_setprio(0); } while (0)
#define PG8_WAIT_V(n) asm volatile("s_waitcnt vmcnt(" #n ")" ::: "memory")
#define PG8_WAIT_L(n) asm volatile("s_waitcnt lgkmcnt(" #n ")" ::: "memory")
#define PG8_BAR __builtin_amdgcn_s_barrier()
#define PG8_SCHED __builtin_amdgcn_sched_barrier(0)
    Unit cur, nxt; int ui = 0;
    if (!S.next(0, cur)) return;
    f32x4 acc[2][2][4][2];
#pragma unroll
    for (int a = 0; a < 2; ++a)
#pragma unroll
        for (int b = 0; b < 2; ++b)
#pragma unroll
            for (int m = 0; m < 4; ++m)
#pragma unroll
                for (int n = 0; n < 2; ++n) acc[a][b][m][n] = (f32x4){0.f, 0.f, 0.f, 0.f};
    bf16x8 At[4][2], B0[2][2], B1[2][2];
    const char* cA = (const char*)g.A + (size_t)cur.pm * tstep; const char* cB = (const char*)g.Bt + (size_t)cur.pn * tstep;
    S.a_ready(cur);
    PG8_STAGE(PG8_SB(0, 0), cB, voffB); PG8_STAGE(PG8_SB(0, 1), cB + hstep, voffB); PG8_STAGE(PG8_SA(0, 0), cA, voffA); PG8_STAGE(PG8_SA(0, 1), cA + hstep, voffA);
    if (wr == 1) PG8_BAR;
    PG8_WAIT_V(2); PG8_BAR;
    PG8_STAGE(PG8_SB(1, 0), cB + kstep, voffB); PG8_STAGE(PG8_SA(1, 0), cA + kstep, voffA); PG8_STAGE(PG8_SB(1, 1), cB + hstep + kstep, voffB);
    PG8_WAIT_V(6); PG8_BAR;
    for (;;) {
        const bool has_next = S.next(ui + 1, nxt);
        const char* nA = has_next ? (const char*)g.A + (size_t)nxt.pm * tstep : cA; const char* nB = has_next ? (const char*)g.Bt + (size_t)nxt.pn * tstep : cB;
        for (int t = 0; t < nt; t += 2) {
            const bool last = (t == nt - 2);
            const char* a1 = cA + (size_t)(t + 1) * kstep;
            const char* a2 = last ? nA : cA + (size_t)(t + 2) * kstep; const char* b2 = last ? nB : cB + (size_t)(t + 2) * kstep;
            const char* a3 = a2 + kstep; const char* b3 = b2 + kstep;
            if (last && has_next) S.a_ready(nxt);
            PG8_LDB(B0, 0, 0); PG8_LDB(B1, 0, 1); PG8_SCHED; PG8_LDA(At, 0, 0); PG8_STAGE(PG8_SA(1, 1), a1 + hstep, voffA);
            PG8_WAIT_V(8); PG8_WAIT_L(0); PG8_BAR; PG8_MMA(0, 0, At, B0); PG8_MMA(0, 1, At, B1); PG8_BAR; PG8_SCHED;
            PG8_LDA(At, 0, 1); PG8_STAGE(PG8_SB(0, 0), b2, voffB); PG8_STAGE(PG8_SB(0, 1), b2 + hstep, voffB); PG8_STAGE(PG8_SA(0, 0), a2, voffA);
            PG8_WAIT_V(8); PG8_WAIT_L(0); PG8_BAR; PG8_MMA(1, 0, At, B0); PG8_MMA(1, 1, At, B1); PG8_BAR; PG8_SCHED;
            PG8_LDB(B0, 1, 0); PG8_LDB(B1, 1, 1); PG8_SCHED; PG8_LDA(At, 1, 0); PG8_STAGE(PG8_SA(0, 1), a2 + hstep, voffA);
            PG8_WAIT_V(8); PG8_WAIT_L(0); PG8_BAR; PG8_MMA(0, 0, At, B0); PG8_MMA(0, 1, At, B1); PG8_BAR; PG8_SCHED;
            PG8_LDA(At, 1, 1); PG8_STAGE(PG8_SB(1, 0), b3, voffB); PG8_STAGE(PG8_SB(1, 1), b3 + hstep, voffB); PG8_STAGE(PG8_SA(1, 0), a3, voffA);
            PG8_WAIT_V(8); PG8_WAIT_L(0); PG8_BAR; PG8_MMA(1, 0, At, B0); PG8_MMA(1, 1, At, B1); PG8_BAR; PG8_SCHED;
        }
        if (wr == 0) PG8_BAR;
        E(acc, cur, wr, wc, fr, fq); S.done(cur);
        if (!has_next) break;
#pragma unroll
        for (int a = 0; a < 2; ++a)
#pragma unroll
            for (int b = 0; b < 2; ++b)
#pragma unroll
                for (int m = 0; m < 4; ++m)
#pragma unroll
                    for (int n = 0; n < 2; ++n) acc[a][b][m][n] = (f32x4){0.f, 0.f, 0.f, 0.f};
        cur = nxt; cA = nA; cB = nB; ++ui;
        if (wr == 1) PG8_BAR;
    }
    PG8_WAIT_V(0);
    PG8_BAR;
#undef PG8_SA
#undef PG8_SB
#undef PG8_STAGE
#undef PG8_LDA
#undef PG8_LDB
#undef PG8_MMA
#undef PG8_WAIT_V
#undef PG8_WAIT_L
#undef PG8_BAR
#undef PG8_SCHED
}
}
using pg8::Unit;

__device__ __forceinline__ float pos_emb(const float* pe, int t, int d) { return d < 1024 ? pe[(t >> 6) * 1024 + d] : pe[(t & 63) * 1024 + (d - 1024)]; }

struct EpiProj {
    static constexpr bool PERM = true;
    bf16_t* O; int ldc;
    __device__ __forceinline__ void operator()(const f32x4 (&acc)[2][2][4][2], const Unit& u, int wr, int wc, int fr, int fq) const {
        const int row0 = u.pm * 256 + wr * 64 + fr, col0 = u.pn * 256 + wc * 32 + 8 * fq;
#pragma unroll
        for (int ai = 0; ai < 2; ++ai)
#pragma unroll
            for (int m = 0; m < 4; ++m) { bf16_t* rowp = O + (size_t)(row0 + ai * 128 + m * 16) * ldc + col0;
#pragma unroll
                for (int bj = 0; bj < 2; ++bj) { const f32x4 v0 = acc[ai][bj][m][0], v1 = acc[ai][bj][m][1];
                    u32x4 w; w.x = cvt_pk_bf16(v0[0], v0[1]); w.y = cvt_pk_bf16(v0[2], v0[3]); w.z = cvt_pk_bf16(v1[0], v1[1]); w.w = cvt_pk_bf16(v1[2], v1[3]);
                    *(u32x4*)(rowp + bj * 128) = w; } }
    }
};
struct EpiLora {
    static constexpr bool PERM = true;
    h16* O; const float* lb;
    __device__ __forceinline__ void operator()(const f32x4 (&acc)[2][2][4][2], const Unit& u, int wr, int wc, int fr, int fq) const {
        const int type = u.pn >> 2;
        if (type == 4 && u.pm >= NTOK / 256) return;
        const int row0 = u.pm * 256 + wr * 64 + fr, cc0 = (u.pn & 3) * 256 + wc * 32 + 8 * fq;
        const float* bias = lb + (type < 4 ? type : 3) * 1024;
        const float bsel = type < 4 ? 1.0f : 0.0f;
        h16* base = O + (size_t)type * LORA_STRIDE;
#pragma unroll
        for (int bj = 0; bj < 2; ++bj) {
            const f32x4 b0 = *(const f32x4*)(bias + cc0 + bj * 128) * bsel, b1 = *(const f32x4*)(bias + cc0 + bj * 128 + 4) * bsel;
#pragma unroll
            for (int ai = 0; ai < 2; ++ai)
#pragma unroll
                for (int m = 0; m < 4; ++m) {
                    const f32x4 v0 = acc[ai][bj][m][0] + b0, v1 = acc[ai][bj][m][1] + b1;
                    u32x4 w;
#pragma unroll
                    for (int i = 0; i < 4; ++i) {
                        const float x0 = i < 2 ? v0[2 * i] : v1[2 * i - 4], x1 = i < 2 ? v0[2 * i + 1] : v1[2 * i - 3];
                        const float s0 = sigmoidf_(x0), s1 = sigmoidf_(x1);
                        const float e0 = __expf(-0.60653066f * s0), e1 = __expf(-0.60653066f * s1);
                        const float r0 = type < 2 ? e0 : (type < 4 ? s0 : x0), r1 = type < 2 ? e1 : (type < 4 ? s1 : x1);
                        w[i] = __builtin_bit_cast(unsigned, __builtin_amdgcn_cvt_pkrtz(r0, r1));
                    }
                    *(u32x4*)(base + (size_t)(row0 + ai * 128 + m * 16) * 1024 + cc0 + bj * 128) = w;
                    asm volatile("" ::: "memory"); __builtin_amdgcn_sched_barrier(0);
                }
        }
    }
};
struct EpiRes {
    static constexpr bool PERM = false;
    const float* resid; const float* pe; const float* gmod; float* out; int use_pos;
    __device__ __forceinline__ void operator()(const f32x4 (&acc)[2][2][4][2], const Unit& u, int wr, int wc, int fr, int fq) const {
        const int row0 = u.pm * 256 + wr * 64 + fr, col0 = u.pn * 256 + wc * 32 + 4 * fq;
#pragma unroll
        for (int ai = 0; ai < 2; ++ai)
#pragma unroll
            for (int m = 0; m < 4; ++m) { const int r = row0 + ai * 128 + m * 16; const int b = r >> 12, t = r & 4095;
#pragma unroll
                for (int bj = 0; bj < 2; ++bj)
#pragma unroll
                    for (int n = 0; n < 2; ++n) { const int c = col0 + bj * 128 + n * 16;
                        f32x4 rs = *(const f32x4*)(resid + (size_t)r * D + c);
                        if (use_pos) { const float* pp = c < 1024 ? pe + (t >> 6) * 1024 + c : pe + (t & 63) * 1024 + (c - 1024); rs += *(const f32x4*)pp; }
                        const f32x4 gv = *(const f32x4*)(gmod + (size_t)b * 6 * D + c);
                        *(f32x4*)(out + (size_t)r * D + c) = rs * ALPHA + gv * acc[ai][bj][m][n]; } }
    }
};
struct EpiSwiglu {
    static constexpr bool PERM = true;
    bf16_t* O;
    __device__ __forceinline__ void operator()(const f32x4 (&acc)[2][2][4][2], const Unit& u, int wr, int wc, int fr, int fq) const {
        const int row0 = u.pm * 256 + wr * 64 + fr, col0 = u.pn * 128 + wc * 32 + 8 * fq;
#pragma unroll
        for (int ai = 0; ai < 2; ++ai)
#pragma unroll
            for (int m = 0; m < 4; ++m) {
                float o[8];
#pragma unroll
                for (int i = 0; i < 8; ++i) { const float a = acc[ai][0][m][i >> 2][i & 3], b = acc[ai][1][m][i >> 2][i & 3]; o[i] = a * sigmoidf_(a) * b; }
                u32x4 w; w.x = cvt_pk_bf16(o[0], o[1]); w.y = cvt_pk_bf16(o[2], o[3]); w.z = cvt_pk_bf16(o[4], o[5]); w.w = cvt_pk_bf16(o[6], o[7]);
                *(u32x4*)(O + (size_t)(row0 + ai * 128 + m * 16) * DFF + col0) = w;
            }
    }
};

constexpr int TRN = 256;
template <class Map>
__device__ __forceinline__ void tr_tile(LAS float* tile, const float* src, int N, int k0, int n0, bf16_t* dst, int ldd, const Map& map) {
    const int tid = threadIdx.x;
    __syncthreads();
    {
        const int n4 = (tid & 63) * 4, kb = tid >> 6;
        f32x4 v[8];
#pragma unroll
        for (int pp = 0; pp < 8; ++pp) { v[pp] = (f32x4){0.f, 0.f, 0.f, 0.f}; if (n0 + n4 < N) v[pp] = *(const f32x4*)(src + (size_t)(k0 + kb + pp * 8) * N + n0 + n4); }
#pragma unroll
        for (int pp = 0; pp < 8; ++pp)
#pragma unroll
            for (int i = 0; i < 4; ++i) tile[(n4 + i) * 65 + kb + pp * 8] = v[pp][i];
    }
    __syncthreads();
    const int n = tid >> 1, ks = (tid & 1) * 32;
    if (n0 + n < N) {
        bf16_t* drow = dst + (size_t)map(n0 + n) * ldd + k0 + ks;
#pragma unroll
        for (int q = 0; q < 4; ++q) {
            float v[8];
#pragma unroll
            for (int i = 0; i < 8; ++i) v[i] = tile[n * 65 + ks + q * 8 + i];
            u32x4 w; w.x = cvt_pk_bf16(v[0], v[1]); w.y = cvt_pk_bf16(v[2], v[3]); w.z = cvt_pk_bf16(v[4], v[5]); w.w = cvt_pk_bf16(v[6], v[7]);
            *(u32x4*)(drow + q * 8) = w;
        }
    }
}
struct MapWin { __device__ int operator()(int n) const { return n < RW_COLS ? n : n + (RWP - RW_COLS); } };
struct MapId { __device__ int operator()(int n) const { return n; } };
struct MapFF { int add; __device__ int operator()(int n) const { return (n >> 7) * 256 + (n & 127) + add; } };

__device__ __forceinline__ void seq_nb(int row, bool& has_prev, bool& has_next) {
    if (row < NTOK) { const int t = row & (SEQ - 1); has_prev = t > 0; has_next = t < SEQ - 1; }
    else { const int t = (row - NTOK) & (CTX - 1); has_prev = t > 0; has_next = t < CTX - 1; }
}

__device__ __forceinline__ void phase_prep(const Params& p, LAS unsigned char* lds) {
    const int tid = threadIdx.x, G = gridDim.x, bid = blockIdx.x;
    unsigned char* ws = p.ws;
    {
        LAS float* tile = (LAS float*)lds;
        bf16_t* WinT = (bf16_t*)(ws + OFF_R1); bf16_t* WoutT = (bf16_t*)(ws + OFF_WOUT);
        const int nt_in = 32 * 26, nt_out = 32 * 8;
        for (int u = bid; u < nt_in + nt_out; u += G) {
            if (u < nt_in) tr_tile(tile, p.in[I_WIN], IN_COLS, (u & 31) * 64, (u >> 5) * TRN, WinT, D, MapWin());
            else { const int v = u - nt_in; tr_tile(tile, p.in[I_WOUT], D, (v & 31) * 64, (v >> 5) * TRN, WoutT, D, MapId()); }
        }
        __syncthreads();
        u32x4* z = (u32x4*)(WinT + (size_t)RW_COLS * D);
        for (int i = bid * NTHREADS + tid; i < (RWP - RW_COLS) * D / 8; i += G * NTHREADS) z[i] = (u32x4){0u, 0u, 0u, 0u};
    }
    {
        bf16_t* Bt2 = (bf16_t*)(ws + OFF_BT2);
        for (int i = bid * NTHREADS + tid; i < NL * KL / 2; i += G * NTHREADS) {
            const int n = (i * 2) / KL, k = (i * 2) % KL, type = n >> 10, col = n & 1023;
            float v[2];
#pragma unroll
            for (int j = 0; j < 2; ++j) { const int kk = k + j; float x = 0.f;
                if (type < 2) { if (kk < 64) x = p.in[type == 0 ? I_WUPF : I_WUPB][kk * 1024 + col]; }
                else if (type < 4) { if (kk >= 64 && kk < 128) x = p.in[type == 2 ? I_AUPF : I_AUPB][(kk - 64) * 1024 + col]; }
                else { if (kk >= 128 && kk < 288) x = p.in[I_GUP][(kk - 128) * 1024 + col]; }
                v[j] = x; }
            ((unsigned*)Bt2)[i] = cvt_pk_bf16(v[0], v[1]);
        }
    }
    {
        LAS float* sv = (LAS float*)lds;
        float* modp = (float*)(ws + OFF_MODP);
        for (int u = bid; u < 256; u += G) {
            const int kc = u >> 3, nc = u & 7;
            __syncthreads();
            if (tid < 320) { const int b = tid >> 6, k = kc * 64 + (tid & 63); const float cv = b < 4 ? p.in[I_C][b * D + k] : p.in[I_CCTX][k]; sv[tid] = cv * sigmoidf_(cv); }
            __syncthreads();
            float acc[5][3];
#pragma unroll
            for (int b = 0; b < 5; ++b)
#pragma unroll
                for (int j = 0; j < 3; ++j) acc[b][j] = 0.f;
            const float* wp = p.in[I_WADA] + (size_t)(kc * 64) * (6 * D) + nc * 1536 + tid;
#pragma unroll 8
            for (int k = 0; k < 64; ++k) {
                const float w0 = wp[(size_t)k * 6 * D], w1 = wp[(size_t)k * 6 * D + 512], w2 = wp[(size_t)k * 6 * D + 1024];
#pragma unroll
                for (int b = 0; b < 5; ++b) { const float s = sv[b * 64 + k]; acc[b][0] += s * w0; acc[b][1] += s * w1; acc[b][2] += s * w2; }
            }
#pragma unroll
            for (int b = 0; b < 5; ++b)
#pragma unroll
                for (int j = 0; j < 3; ++j) modp[((size_t)kc * 5 + b) * (6 * D) + nc * 1536 + tid + j * 512] = acc[b][j];
        }
    }
    {
        LAS float* zs = (LAS float*)lds;
        LAS float* h1 = zs + 16 * 33;
        float* h2 = (float*)(ws + OFF_H2);
        for (int u = bid; u < 256; u += G) {
            __syncthreads();
            for (int i = tid; i < 16 * 33; i += NTHREADS) { const int pl = i / 33, j = i % 33; const int pos = u * 16 + pl; float v;
                if (j == 0) v = (float)pos / 4095.0f;
                else { const int bi = (j - 1) & 15; const float band = 1e-4f + (float)bi * ((15.0f - 1e-4f) / 15.0f);
                    const float ang = 6.283185307179586f * band * (float)pos / 4096.0f; v = j <= 16 ? cosf(ang) : -sinf(ang); }
                zs[i] = v; }
            __syncthreads();
            const int pl = tid >> 5, l32 = tid & 31;
#pragma unroll
            for (int oo = 0; oo < 2; ++oo) { const int o = l32 + oo * 32; float s = p.in[I_FB1][o];
#pragma unroll 3
                for (int i = 0; i < 33; ++i) s += zs[pl * 33 + i] * p.in[I_FW1][i * 64 + o];
                h1[pl * 64 + o] = sinf(p.in[I_SINF][o] * s); }
            __syncthreads();
#pragma unroll
            for (int oo = 0; oo < 2; ++oo) { const int o = l32 + oo * 32; float s = p.in[I_FB2][o];
#pragma unroll 4
                for (int i = 0; i < 64; ++i) s += h1[pl * 64 + i] * p.in[I_FW2][i * 64 + o];
                h2[(size_t)(u * 16 + pl) * 64 + o] = sinf(p.in[I_SINF][o] * s); }
        }
    }
    { float* lb = (float*)(ws + OFF_LB);
      for (int i = bid * NTHREADS + tid; i < 4096; i += G * NTHREADS) { const int ty = i >> 10, c = i & 1023; lb[i] = p.in[ty == 0 ? I_W0F : ty == 1 ? I_W0B : ty == 2 ? I_A0F : I_A0B][c]; } }
    {
        float* pe = (float*)(ws + OFF_PE);
        for (int i = bid * NTHREADS + tid; i < 64 * 1024; i += G * NTHREADS) {
            const int r = i >> 10, d = i & 1023, q = d & 511;
            const float omega = 1.0f / powf(10000.0f, (float)q / 512.0f);
            const float a = (float)r * omega;
            pe[i] = d < 512 ? sinf(a) : cosf(a);
        }
    }
}

__device__ __forceinline__ void phase_modfin(const Params& p) {
    float* mod = (float*)(p.ws + OFF_MOD); const float* modp = (const float*)(p.ws + OFF_MODP);
    for (int i = blockIdx.x * NTHREADS + threadIdx.x; i < 5 * 6 * D; i += gridDim.x * NTHREADS) {
        float s = p.in[I_BADA][i % (6 * D)];
        for (int kc = 0; kc < 32; ++kc) s += modp[(size_t)kc * 5 * 6 * D + i];
        mod[i] = s;
    }
    {
        const float* h2 = (const float*)(p.ws + OFF_H2); const float* w3 = p.in[I_FW3]; float* HFT = p.out;
        const int lane = threadIdx.x & 63, wv = __builtin_amdgcn_readfirstlane(threadIdx.x >> 6);
        for (int u = blockIdx.x; u < 512; u += gridDim.x) {
            const int pt = u >> 3, cb = u & 7;
            f32x4 hr[16];
#pragma unroll
            for (int q = 0; q < 16; ++q) hr[q] = *(const f32x4*)(h2 + (size_t)(pt * 64 + lane) * 64 + q * 4);
            const int c0 = cb * 256 + wv * 32;
            for (int cc = 0; cc < 32; cc += 4) {
                float a0 = 0.f, a1 = 0.f, a2 = 0.f, a3 = 0.f;
#pragma unroll
                for (int q = 0; q < 16; ++q) {
#pragma unroll
                    for (int jj = 0; jj < 4; ++jj) { const f32x4 wq = *(const f32x4*)(w3 + (size_t)(q * 4 + jj) * 2048 + c0 + cc); const float hv = hr[q][jj];
                        a0 += hv * wq[0]; a1 += hv * wq[1]; a2 += hv * wq[2]; a3 += hv * wq[3]; }
                    if ((q & 3) == 3) __builtin_amdgcn_sched_barrier(0);
                }
                float* o = HFT + (size_t)(c0 + cc) * 4096 + pt * 64 + lane;
                o[0] = a0; o[4096] = a1; o[2 * 4096] = a2; o[3 * 4096] = a3;
            }
        }
    }
}

__device__ __forceinline__ void phase_a1(const Params& p) {
    const float* mod = (const float*)(p.ws + OFF_MOD); const float* pe = (const float*)(p.ws + OFF_PE);
    bf16_t* A1 = (bf16_t*)(p.ws + OFF_R4);
    for (int i = blockIdx.x * NTHREADS + threadIdx.x; i < (MROWS / 4) * (D / 4); i += gridDim.x * NTHREADS) {
        const int r0 = (i >> 9) * 4, d = (i & 511) * 4;
        const bool lat = r0 < NTOK; const int mb = lat ? (r0 >> 12) : 4;
        const float* src = lat ? p.in[I_X] + (size_t)r0 * D + d : p.in[I_CTX] + (size_t)(r0 - NTOK) * D + d;
        f32x4 v[4];
#pragma unroll
        for (int j = 0; j < 4; ++j) v[j] = *(const f32x4*)(src + (size_t)j * D);
        const f32x4 sh = *(const f32x4*)(mod + (size_t)mb * 6 * D + d), sc = *(const f32x4*)(mod + (size_t)mb * 6 * D + D + d) + 1.0f;
        if (lat) {
            const int t = r0 & 4095;
#pragma unroll
            for (int j = 0; j < 4; ++j) { const float* pp = d < 1024 ? pe + (t >> 6) * 1024 + d : pe + ((t + j) & 63) * 1024 + (d - 1024); v[j] += *(const f32x4*)pp; }
        }
#pragma unroll
        for (int j = 0; j < 4; ++j) { const f32x4 o = v[j] * sc + sh; u32x2 w; w.x = cvt_pk_bf16(o[0], o[1]); w.y = cvt_pk_bf16(o[2], o[3]); *(u32x2*)(A1 + (size_t)(r0 + j) * D + d) = w; }
    }
}

__device__ __forceinline__ void ld8(const bf16_t* ptr, bool valid, float (&o)[8]) {
    u32x4 w = (u32x4){0u, 0u, 0u, 0u};
    if (valid) w = *(const u32x4*)ptr;
#pragma unroll
    for (int i = 0; i < 4; ++i) { o[2 * i] = __uint_as_float(w[i] << 16); o[2 * i + 1] = __uint_as_float(w[i] & 0xffff0000u); }
}
__device__ __forceinline__ void conv8(const bf16_t* proj, int row, bool hp, bool hn, int col, const float* cw, int ldw, int wcol, float (&o)[8]) {
    float a[8], b[8], c[8];
    const bf16_t* pr = proj + (size_t)row * NP + col;
    ld8(pr - NP, hp, a); ld8(pr, true, b); ld8(pr + NP, hn, c);
#pragma unroll
    for (int i = 0; i < 8; ++i) o[i] = cw[wcol + i] * a[i] + cw[ldw + wcol + i] * b[i] + cw[2 * ldw + wcol + i] * c[i];
}

__device__ __forceinline__ void hy_raw3(const bf16_t* pr, bool hp, bool hn, u32x4 (&r)[3]) {
    const u32x4 z = (u32x4){0u, 0u, 0u, 0u};
    r[0] = hp ? *(const u32x4*)(pr - NP) : z; r[1] = *(const u32x4*)pr; r[2] = hn ? *(const u32x4*)(pr + NP) : z;
}
__device__ __forceinline__ void hy_raw2(const bf16_t* proj, int u, int tl, int cs, u32x4 (&ra)[3], u32x4 (&rb)[3]) {
    const int ct = u & 15, tt = (u >> 4) & 63, b = u >> 10, t = tt * 64 + tl, c = ct * 64 + cs;
    const bf16_t* pr = proj + (size_t)(b * SEQ + t) * NP + RWP + c;
    hy_raw3(pr + 1024, t > 0, t < SEQ - 1, ra); hy_raw3(pr + 2048, t > 0, t < SEQ - 1, rb);
}
struct HyW { float w[3][8]; float b[8]; };
__device__ __forceinline__ void hy_wload(HyW& W, const float* cw, const float* bias, int ldw, int wcol) {
#pragma unroll
    for (int i = 0; i < 8; ++i) { W.w[0][i] = cw[wcol + i]; W.w[1][i] = cw[ldw + wcol + i]; W.w[2][i] = cw[2 * ldw + wcol + i]; W.b[i] = bias[wcol + i]; }
}
__device__ __forceinline__ void hy_convw(const u32x4 (&r)[3], const HyW& W, float (&o)[8]) {
#pragma unroll
    for (int i = 0; i < 8; ++i) {
        const float a = (i & 1) ? __uint_as_float(r[0][i >> 1] & 0xffff0000u) : __uint_as_float(r[0][i >> 1] << 16);
        const float b = (i & 1) ? __uint_as_float(r[1][i >> 1] & 0xffff0000u) : __uint_as_float(r[1][i >> 1] << 16);
        const float c = (i & 1) ? __uint_as_float(r[2][i >> 1] & 0xffff0000u) : __uint_as_float(r[2][i >> 1] << 16);
        o[i] = W.w[0][i] * a + W.w[1][i] * b + W.w[2][i] * c + W.b[i];
    }
}
__device__ __forceinline__ void hy_conv(const u32x4 (&r)[3], const float* cw, int ldw, int wcol, float (&o)[8]) {
#pragma unroll
    for (int i = 0; i < 8; ++i) {
        const float a = (i & 1) ? __uint_as_float(r[0][i >> 1] & 0xffff0000u) : __uint_as_float(r[0][i >> 1] << 16);
        const float b = (i & 1) ? __uint_as_float(r[1][i >> 1] & 0xffff0000u) : __uint_as_float(r[1][i >> 1] << 16);
        const float c = (i & 1) ? __uint_as_float(r[2][i >> 1] & 0xffff0000u) : __uint_as_float(r[2][i >> 1] << 16);
        o[i] = cw[wcol + i] * a + cw[ldw + wcol + i] * b + cw[2 * ldw + wcol + i] * c;
    }
}

__device__ __forceinline__ void phase_post_proj(const Params& p, LAS unsigned char* lds) {
    const int tid = threadIdx.x, G = gridDim.x, bid = blockIdx.x;
    const bf16_t* proj = (const bf16_t*)(p.ws + OFF_R5);
    bf16_t* A2 = (bf16_t*)(p.ws + OFF_R1);
    LAS float* cwl = (LAS float*)lds;
    __syncthreads();
    for (int i = tid; i < 3 * 288; i += NTHREADS) cwl[i] = p.in[I_CONVRW][(i / 288) * RW_COLS + 3072 + (i % 288)];
    __syncthreads();
    for (size_t i = (size_t)bid * NTHREADS + tid; i < (size_t)MROWS * 48; i += (size_t)G * NTHREADS) {
        const int row = (int)(i / 48), g = (int)(i % 48);
        u32x4 w = (u32x4){0u, 0u, 0u, 0u};
        if (g < 36) { bool hp, hn; seq_nb(row, hp, hn); float v[8];
            { float a[8], b[8], c[8];
              const bf16_t* pr = proj + (size_t)row * NP + 3072 + g * 8;
              ld8(pr - NP, hp, a); ld8(pr, true, b); ld8(pr + NP, hn, c);
              const f32x4 w0a = *(const LAS f32x4*)(cwl + g * 8), w0b = *(const LAS f32x4*)(cwl + g * 8 + 4), w1a = *(const LAS f32x4*)(cwl + 288 + g * 8), w1b = *(const LAS f32x4*)(cwl + 288 + g * 8 + 4),
                          w2a = *(const LAS f32x4*)(cwl + 576 + g * 8), w2b = *(const LAS f32x4*)(cwl + 576 + g * 8 + 4);
#pragma unroll
              for (int j = 0; j < 4; ++j) { v[j] = w0a[j] * a[j] + w1a[j] * b[j] + w2a[j] * c[j]; v[4 + j] = w0b[j] * a[4 + j] + w1b[j] * b[4 + j] + w2b[j] * c[4 + j]; } }
#pragma unroll
            for (int j = 0; j < 8; ++j) { const float th = 1.0f - 2.0f * __builtin_amdgcn_rcpf(1.0f + __expf(2.0f * v[j])), sg = sigmoidf_(v[j]); v[j] = g < 8 ? th : (g >= 16 ? sg : v[j]); }
            w.x = cvt_pk_bf16(v[0], v[1]); w.y = cvt_pk_bf16(v[2], v[3]); w.z = cvt_pk_bf16(v[4], v[5]); w.w = cvt_pk_bf16(v[6], v[7]); }
        *(u32x4*)(A2 + (size_t)row * KL + g * 8) = w;
    }
    LAS float* tile = (LAS float*)lds;
    bf16_t* zT = (bf16_t*)(p.ws + OFF_R4);
    {
        const int tl = tid >> 3, cs = (tid & 7) * 8;
        u32x4 ra[3], rb[3], na[3], nb[3];
        HyW W1, W2; int ctw = -1;
        if (bid < 4096) hy_raw2(proj, bid, tl, cs, ra, rb);
        for (int u = bid; u < 4096; u += G) {
            const int ct = u & 15, tt = (u >> 4) & 63, b = u >> 10, c = ct * 64 + cs;
            hy_raw2(proj, u + G < 4096 ? u + G : u, tl, cs, na, nb);
            float x1[8], vv[8];
            if (ct != ctw) { hy_wload(W1, p.in[I_CONVHY], p.in[I_CONVHYB], 3072, 1024 + c); hy_wload(W2, p.in[I_CONVHY], p.in[I_CONVHYB], 3072, 2048 + c); ctw = ct; }
            hy_convw(ra, W1, x1); hy_convw(rb, W2, vv);
            __syncthreads();
#pragma unroll
            for (int i = 0; i < 8; ++i) tile[(cs + i) * 65 + tl] = vv[i] * x1[i];
            __syncthreads();
            const int cl = tid >> 3, ts = (tid & 7) * 8;
            f32x4 o0, o1;
#pragma unroll
            for (int i = 0; i < 4; ++i) { o0[i] = tile[cl * 65 + ts + i]; o1[i] = tile[cl * 65 + ts + 4 + i]; }
            bf16_t* dst = zT + ((size_t)(b * 1024 + ct * 64 + cl)) * SEQ + tt * 64 + ts;
            u32x4 zw; zw.x = cvt_pk_bf16(o0[0], o0[1]); zw.y = cvt_pk_bf16(o0[2], o0[3]); zw.z = cvt_pk_bf16(o1[0], o1[1]); zw.w = cvt_pk_bf16(o1[2], o1[3]);
            *(u32x4*)dst = zw;
#pragma unroll
            for (int i = 0; i < 3; ++i) { ra[i] = na[i]; rb[i] = nb[i]; }
        }
    }
}

__device__ __forceinline__ int fpad(int n) { return n + ((n >> 5) << 1); }
__device__ __forceinline__ f32x2 cmul(f32x2 a, f32x2 b) { return (f32x2){b.x, b.x} * a + (f32x2){b.y, b.y} * (f32x2){-a.y, a.x}; }
__device__ __forceinline__ f32x2 cmulc(f32x2 a, f32x2 b) { return (f32x2){b.x, b.x} * a + (f32x2){b.y, b.y} * (f32x2){a.y, -a.x}; }

template <int LO> __device__ __forceinline__ int fft_base(int g) { return ((g >> LO) << (LO + 4)) | (g & ((1 << LO) - 1)); }
template <int LO> __device__ __forceinline__ void fft_load(const LAS f32x2* x, int base, f32x2 (&v)[16]) {
#pragma unroll
    for (int r = 0; r < 16; ++r) v[r] = x[fpad(base | (r << LO))];
}
template <int LO> __device__ __forceinline__ void fft_store(LAS f32x2* x, int base, const f32x2 (&v)[16]) {
#pragma unroll
    for (int r = 0; r < 16; ++r) x[fpad(base | (r << LO))] = v[r];
}
template <int LO> __device__ __forceinline__ void fft_twset(const LAS f32x2* tw, int g, f32x2 (&T)[4]) {
    const int gl = g & ((1 << LO) - 1);
#pragma unroll
    for (int sb = 0; sb < 4; ++sb) T[sb] = tw[gl << (12 - LO - sb)];
}
template <int SB, int M> __device__ __forceinline__ f32x2 cconst() { const float ang = -6.283185307179586f * (float)M / (float)(2 << SB); return (f32x2){__builtin_cosf(ang), __builtin_sinf(ang)}; }
template <int SB, int R> __device__ __forceinline__ void bfly_fwd(const f32x2 (&T)[4], f32x2 (&v)[16]) {
    if constexpr (!(R & (1 << SB))) {
        constexpr int R2 = R | (1 << SB), M = R & ((1 << SB) - 1);
        const f32x2 a = v[R], b = v[R2];
        v[R] = a + b; f32x2 d = a - b;
        if constexpr (M != 0) d = cmul(d, cconst<SB, M>());
        v[R2] = cmul(d, T[SB]);
    }
}
template <int SB, int R> __device__ __forceinline__ void bfly_inv(const f32x2 (&T)[4], f32x2 (&v)[16]) {
    if constexpr (!(R & (1 << SB))) {
        constexpr int R2 = R | (1 << SB), M = R & ((1 << SB) - 1);
        f32x2 b = cmulc(v[R2], T[SB]);
        if constexpr (M != 0) b = cmulc(b, cconst<SB, M>());
        const f32x2 a = v[R];
        v[R] = a + b; v[R2] = a - b;
    }
}
template <int SB> __device__ __forceinline__ void stage_fwd(const f32x2 (&T)[4], f32x2 (&v)[16]) {
    bfly_fwd<SB, 0>(T, v); bfly_fwd<SB, 1>(T, v); bfly_fwd<SB, 2>(T, v); bfly_fwd<SB, 3>(T, v); bfly_fwd<SB, 4>(T, v); bfly_fwd<SB, 5>(T, v); bfly_fwd<SB, 6>(T, v); bfly_fwd<SB, 7>(T, v);
    bfly_fwd<SB, 8>(T, v); bfly_fwd<SB, 9>(T, v); bfly_fwd<SB, 10>(T, v); bfly_fwd<SB, 11>(T, v); bfly_fwd<SB, 12>(T, v); bfly_fwd<SB, 13>(T, v); bfly_fwd<SB, 14>(T, v); bfly_fwd<SB, 15>(T, v);
}
template <int SB> __device__ __forceinline__ void stage_inv(const f32x2 (&T)[4], f32x2 (&v)[16]) {
    bfly_inv<SB, 0>(T, v); bfly_inv<SB, 1>(T, v); bfly_inv<SB, 2>(T, v); bfly_inv<SB, 3>(T, v); bfly_inv<SB, 4>(T, v); bfly_inv<SB, 5>(T, v); bfly_inv<SB, 6>(T, v); bfly_inv<SB, 7>(T, v);
    bfly_inv<SB, 8>(T, v); bfly_inv<SB, 9>(T, v); bfly_inv<SB, 10>(T, v); bfly_inv<SB, 11>(T, v); bfly_inv<SB, 12>(T, v); bfly_inv<SB, 13>(T, v); bfly_inv<SB, 14>(T, v); bfly_inv<SB, 15>(T, v);
}
template <int LO> __device__ __forceinline__ void fft_fwd(const f32x2 (&T)[4], f32x2 (&v)[16]) { stage_fwd<3>(T, v); stage_fwd<2>(T, v); stage_fwd<1>(T, v); stage_fwd<0>(T, v); }
template <int LO> __device__ __forceinline__ void fft_inv(const f32x2 (&T)[4], f32x2 (&v)[16]) { stage_inv<0>(T, v); stage_inv<1>(T, v); stage_inv<2>(T, v); stage_inv<3>(T, v); }
__device__ __forceinline__ void fft_fwd0(const LAS f32x2* tw, f32x2 (&v)[16]) {
#pragma unroll
    for (int sb = 3; sb >= 0; --sb) {
#pragma unroll
        for (int r = 0; r < 16; ++r) if (!(r & (1 << sb))) {
            const int r2 = r | (1 << sb);
            const f32x2 a = v[r], b = v[r2];
            v[r] = a + b; v[r2] = cmul(a - b, tw[(r & ((1 << sb) - 1)) << (12 - sb)]);
        }
    }
}
__device__ __forceinline__ void fft_inv0(const LAS f32x2* tw, f32x2 (&v)[16]) {
#pragma unroll
    for (int sb = 0; sb < 4; ++sb) {
#pragma unroll
        for (int r = 0; r < 16; ++r) if (!(r & (1 << sb))) {
            const int r2 = r | (1 << sb);
            const f32x2 a = v[r], b = cmulc(v[r2], tw[(r & ((1 << sb) - 1)) << (12 - sb)]);
            v[r] = a + b; v[r2] = a - b;
        }
    }
}

__device__ __forceinline__ void phase_hyena_fft(const Params& p, LAS unsigned char* lds) {
    const int tid = threadIdx.x, G = gridDim.x, bid = blockIdx.x;
    LAS f32x2* x = (LAS f32x2*)lds;
    LAS f32x2* tw = (LAS f32x2*)(lds + 8704 * 8);
    __syncthreads();
    for (int k = tid; k < 4096; k += NTHREADS) { const float rev = (float)k * (1.0f / 8192.0f); tw[k] = (f32x2){__builtin_amdgcn_cosf(rev), -__builtin_amdgcn_sinf(rev)}; }
    const float* h2 = (const float*)(p.ws + OFF_H2);
    bf16_t* zT = (bf16_t*)(p.ws + OFF_R4);
    const float* HFT = p.out;
    f32x2 v[16], kf[16], T8[4], T4[4];
    __syncthreads();
    fft_twset<8>(tw, tid, T8); fft_twset<4>(tw, tid, T4);
#ifndef FFT_REPS
#define FFT_REPS 1
#endif
    for (int c = bid; c < HY; c += G) for (int frep = 0; frep < FFT_REPS; ++frep) {
        __syncthreads();
        {
            const float delta = fabsf(-3.0701134573253945f + (float)c * ((-15.350567286626973f + 3.0701134573253945f) / 1023.0f));
            const float bias = p.in[I_HYB][c];
#pragma unroll 2
            for (int i = 0; i < 8; ++i) {
                const int n = tid + i * NTHREADS;
                const int nb = n == 0 ? 0 : 4096 - n;
                const float sf = HFT[(size_t)c * 4096 + n], sb = HFT[(size_t)(1024 + c) * 4096 + nb];
                float klo = sf * __expf(-((float)n * (1.0f / 4095.0f)) * delta), khi = sb * __expf(-((float)nb * (1.0f / 4095.0f)) * delta);
                if (n == 0) { klo += bias; khi = 0.f; }
                const f32x2 d = (f32x2){klo - khi, 0.f};
                x[fpad(n)] = (f32x2){klo + khi, 0.f}; x[fpad(n + 4096)] = cmul(d, tw[n]);
            }
        }
        __syncthreads();
        { const int b8 = fft_base<8>(tid); fft_load<8>(x, b8, v); fft_fwd<8>(T8, v); fft_store<8>(x, b8, v); }
        __syncthreads();
        { const int b4 = fft_base<4>(tid); fft_load<4>(x, b4, v); fft_fwd<4>(T4, v); fft_store<4>(x, b4, v); }
        __syncthreads();
        { const int b0 = fft_base<0>(tid); fft_load<0>(x, b0, kf); fft_fwd0(tw, kf); }
#pragma unroll
        for (int r = 0; r < 16; ++r) kf[r] *= (1.0f / 8192.0f);
        for (int pair = 0; pair < 2; ++pair) {
            bf16_t* z0 = zT + ((size_t)((2 * pair) * 1024 + c)) * SEQ; bf16_t* z1 = zT + ((size_t)((2 * pair + 1) * 1024 + c)) * SEQ;
            __syncthreads();
#pragma unroll 2
            for (int i = 0; i < 8; ++i) { const int n = tid + i * NTHREADS; const f32x2 a = (f32x2){bf2f(z0[n]), bf2f(z1[n])}; x[fpad(n)] = a; x[fpad(n + 4096)] = cmul(a, tw[n]); }
            __syncthreads();
            { const int b8 = fft_base<8>(tid); fft_load<8>(x, b8, v); fft_fwd<8>(T8, v); fft_store<8>(x, b8, v); }
            __syncthreads();
            { const int b4 = fft_base<4>(tid); fft_load<4>(x, b4, v); fft_fwd<4>(T4, v); fft_store<4>(x, b4, v); }
            __syncthreads();
            { const int b0 = fft_base<0>(tid); fft_load<0>(x, b0, v); fft_fwd0(tw, v);
#pragma unroll
              for (int r = 0; r < 16; ++r) v[r] = cmul(v[r], kf[r]);
              fft_inv0(tw, v); fft_store<0>(x, b0, v); }
            __syncthreads();
            { const int b4 = fft_base<4>(tid); fft_load<4>(x, b4, v); fft_inv<4>(T4, v); fft_store<4>(x, b4, v); }
            __syncthreads();
            { const int b8 = fft_base<8>(tid); fft_load<8>(x, b8, v); fft_inv<8>(T8, v); fft_store<8>(x, b8, v); }
            __syncthreads();
#pragma unroll 2
            for (int i = 0; i < 8; ++i) { const int n = tid + i * NTHREADS; const f32x2 y = x[fpad(n)] + cmulc(x[fpad(n + 4096)], tw[n]); if (frep == FFT_REPS - 1) { const unsigned pk = cvt_pk_bf16(y.x, y.y); z0[n] = (bf16_t)(pk & 0xffffu); z1[n] = (bf16_t)(pk >> 16); } }
        }
    }
}

struct ScanRaw { u32x4 pr[3], pk[3], pv[3]; u32x4 w, a; };
constexpr int SC_T = 32;
constexpr int SC_BUF = (5 * SC_T * 64 + SC_T * 32) * 4;
constexpr int SC_NCH = (CTX + SEQ) / SC_T;

__device__ __forceinline__ void scan_rows(int ci, int st, int dir, int b, int& row, bool& hp, bool& hn, bool& latent, int& t) {
    int sg = ci * SC_T + st;
    if (sg < CTX) { t = dir ? CTX - 1 - sg : sg; row = NTOK + b * CTX + t; hp = t > 0; hn = t < CTX - 1; latent = false; }
    else { sg -= CTX; t = dir ? SEQ - 1 - sg : sg; row = b * SEQ + t; hp = t > 0; hn = t < SEQ - 1; latent = true; }
}
__device__ __forceinline__ void scan_issue(const bf16_t* proj, const h16* wd, const h16* ad, int ci, int st, int dir, int b, int ch, ScanRaw& q) {
    int row, t; bool hp, hn, lat; scan_rows(ci, st, dir, b, row, hp, hn, lat, t);
    const bf16_t* pr = proj + (size_t)row * NP + ch;
    const u32x4 z = (u32x4){0u, 0u, 0u, 0u};
    q.pr[0] = hp ? *(const u32x4*)(pr - NP) : z; q.pr[1] = *(const u32x4*)pr; q.pr[2] = hn ? *(const u32x4*)(pr + NP) : z;
    q.pk[0] = hp ? *(const u32x4*)(pr - NP + 1024) : z; q.pk[1] = *(const u32x4*)(pr + 1024); q.pk[2] = hn ? *(const u32x4*)(pr + NP + 1024) : z;
    q.pv[0] = hp ? *(const u32x4*)(pr - NP + 2048) : z; q.pv[1] = *(const u32x4*)(pr + 2048); q.pv[2] = hn ? *(const u32x4*)(pr + NP + 2048) : z;
    q.w = *(const u32x4*)(wd + (size_t)row * 1024 + ch); q.a = *(const u32x4*)(ad + (size_t)row * 1024 + ch);
}
__device__ __forceinline__ float bfe(const u32x4& w, int i) { return (i & 1) ? __uint_as_float(w[i >> 1] & 0xffff0000u) : __uint_as_float(w[i >> 1] << 16); }
__device__ __forceinline__ float h16e(const u32x4& w, int i) { const unsigned short s = (unsigned short)((i & 1) ? (w[i >> 1] >> 16) : (w[i >> 1] & 0xffffu)); return (float)__builtin_bit_cast(h16, s); }

struct ScanOps { f32x4 r[2], w[2], k[2], a[2], b[2]; float v; };
__device__ __forceinline__ void scan_ld(ScanOps& o, const LAS float* R, const LAS float* Vp, int sidx) {
#pragma unroll
    for (int q = 0; q < 2; ++q) { o.r[q] = *(const LAS f32x4*)(R + sidx * 64 + q * 32); o.w[q] = *(const LAS f32x4*)(R + SC_T * 64 + sidx * 64 + q * 32); o.k[q] = *(const LAS f32x4*)(R + 2 * SC_T * 64 + sidx * 64 + q * 32);
        o.a[q] = *(const LAS f32x4*)(R + 3 * SC_T * 64 + sidx * 64 + q * 32); o.b[q] = *(const LAS f32x4*)(R + 4 * SC_T * 64 + sidx * 64 + q * 32); }
    o.v = Vp[sidx * 32];
}
__device__ __forceinline__ void scan_step(f32x2 (&s2)[4], const ScanOps& c) {
    f32x2 p0 = s2[0] * (f32x2){c.a[0][0], c.a[0][1]}, p1 = s2[2] * (f32x2){c.a[1][0], c.a[1][1]};
    p0 = s2[1] * (f32x2){c.a[0][2], c.a[0][3]} + p0; p1 = s2[3] * (f32x2){c.a[1][2], c.a[1][3]} + p1;
    p0 += p1;
    const float pa = sum8(p0.x + p0.y);
    const f32x2 vv2 = (f32x2){c.v, c.v}, pa2 = (f32x2){pa, pa};
    const f32x2 t0 = s2[0] * (f32x2){c.w[0][0], c.w[0][1]} + vv2 * (f32x2){c.k[0][0], c.k[0][1]};
    const f32x2 t1 = s2[1] * (f32x2){c.w[0][2], c.w[0][3]} + vv2 * (f32x2){c.k[0][2], c.k[0][3]};
    const f32x2 t2 = s2[2] * (f32x2){c.w[1][0], c.w[1][1]} + vv2 * (f32x2){c.k[1][0], c.k[1][1]};
    const f32x2 t3 = s2[3] * (f32x2){c.w[1][2], c.w[1][3]} + vv2 * (f32x2){c.k[1][2], c.k[1][3]};
    s2[0] = pa2 * (f32x2){c.b[0][0], c.b[0][1]} + t0; s2[1] = pa2 * (f32x2){c.b[0][2], c.b[0][3]} + t1;
    s2[2] = pa2 * (f32x2){c.b[1][0], c.b[1][1]} + t2; s2[3] = pa2 * (f32x2){c.b[1][2], c.b[1][3]} + t3;
}

__device__ __forceinline__ void phase_scan(const Params& p, LAS unsigned char* lds) {
    const int tid = threadIdx.x, G = gridDim.x;
    const bf16_t* proj = (const bf16_t*)(p.ws + OFF_R5);
    const h16* lora = (const h16*)(p.ws + OFF_R6);
    LAS float* cw = (LAS float*)(lds + 2 * SC_BUF);
    for (int u = blockIdx.x; u < 256; u += G) {
        const int half = u & 1, sc = u >> 1, dir = sc >> 6, b = (sc >> 4) & 3, h = sc & 15;
        const h16* wd = lora + (size_t)dir * LORA_STRIDE; const h16* ad = lora + (size_t)(2 + dir) * LORA_STRIDE;
        float* yout = p.out + (size_t)dir * NTOK * 1024;
        __syncthreads();
        for (int i = tid; i < 9 * 64 + 128; i += NTHREADS) {
            float v;
            if (i < 576) { const int which = i / 192, tap = (i / 64) % 3, j = i & 63; v = p.in[I_CONVRW][tap * RW_COLS + which * 1024 + h * 64 + j]; }
            else if (i < 640) v = p.in[I_KK][h * 64 + (i - 576)];
            else v = p.in[I_KA][h * 64 + (i - 640)];
            cw[i] = v;
        }
        __syncthreads();
        const bool producer = tid >= 256;
        const int ptid = tid & 255, st = ptid >> 3, e = ptid & 7;
        ScanRaw raw;
        f32x2 s2[4];
#pragma unroll
        for (int j = 0; j < 4; ++j) s2[j] = (f32x2){0.f, 0.f};
        if (producer) scan_issue(proj, wd, ad, 0, st, dir, b, h * 64 + e * 8, raw);
        for (int ci = -1; ci < SC_NCH; ++ci) {
            if (producer) {
                if (ci + 1 < SC_NCH) {
                    LAS float* buf = (LAS float*)(lds + ((ci + 1) & 1) * SC_BUF);
                    float r[8], k[8], vv[8], kkv[8], w[8], a[8];
                    float nrm = 0.f;
#pragma unroll
                    for (int j = 0; j < 8; ++j) { const int cj = e * 8 + j;
                        r[j] = cw[0 * 64 + cj] * bfe(raw.pr[0], j) + cw[1 * 64 + cj] * bfe(raw.pr[1], j) + cw[2 * 64 + cj] * bfe(raw.pr[2], j);
                        k[j] = cw[3 * 64 + cj] * bfe(raw.pk[0], j) + cw[4 * 64 + cj] * bfe(raw.pk[1], j) + cw[5 * 64 + cj] * bfe(raw.pk[2], j);
                        vv[j] = cw[6 * 64 + cj] * bfe(raw.pv[0], j) + cw[7 * 64 + cj] * bfe(raw.pv[1], j) + cw[8 * 64 + cj] * bfe(raw.pv[2], j);
                        kkv[j] = k[j] * cw[576 + cj]; nrm += kkv[j] * kkv[j];
                        w[j] = h16e(raw.w, j); a[j] = h16e(raw.a, j); }
                    nrm = sum8(nrm);
                    const float inv = __builtin_amdgcn_rsqf(fmaxf(nrm, 1e-24f));
                    f32x4 o;
                    LAS float* R = buf + st * 64 + e * 4;
#pragma unroll
                    for (int q = 0; q < 2; ++q) {
#pragma unroll
                        for (int j = 0; j < 4; ++j) o[j] = r[q * 4 + j];
                        *(LAS f32x4*)(R + q * 32) = o;
#pragma unroll
                        for (int j = 0; j < 4; ++j) o[j] = w[q * 4 + j];
                        *(LAS f32x4*)(R + SC_T * 64 + q * 32) = o;
#pragma unroll
                        for (int j = 0; j < 4; ++j) o[j] = k[q * 4 + j] * (1.0f + (a[q * 4 + j] - 1.0f) * cw[640 + e * 8 + q * 4 + j]);
                        *(LAS f32x4*)(R + 2 * SC_T * 64 + q * 32) = o;
#pragma unroll
                        for (int j = 0; j < 4; ++j) o[j] = -kkv[q * 4 + j] * inv;
                        *(LAS f32x4*)(R + 3 * SC_T * 64 + q * 32) = o;
#pragma unroll
                        for (int j = 0; j < 4; ++j) o[j] = kkv[q * 4 + j] * inv * a[q * 4 + j];
                        *(LAS f32x4*)(R + 4 * SC_T * 64 + q * 32) = o;
                    }
                    if ((e >> 2) == half) {
                        LAS float* V = buf + 5 * SC_T * 64 + st * 32 + (e & 3) * 8;
#pragma unroll
                        for (int q = 0; q < 2; ++q) {
#pragma unroll
                            for (int j = 0; j < 4; ++j) o[j] = vv[q * 4 + j];
                            *(LAS f32x4*)(V + q * 4) = o; }
                    }
                    if (ci + 2 < SC_NCH) scan_issue(proj, wd, ad, ci + 2, st, dir, b, h * 64 + e * 8, raw);
                }
            } else if (ci >= 0) {
                __builtin_amdgcn_s_setprio(2);
                const LAS float* buf = (const LAS float*)(lds + (ci & 1) * SC_BUF);
                const int rowi = ptid >> 3;
                const bool latent = ci >= CTX / SC_T;
                const LAS float* R = buf + e * 4;
                const LAS float* Vp = buf + 5 * SC_T * 64 + rowi;
                ScanOps c0, c1, c2;
                scan_ld(c0, R, Vp, 0); scan_ld(c1, R, Vp, 1);
                if (latent) {
                    const int sg0 = ci * SC_T - CTX; const int t0 = dir ? SEQ - 1 - sg0 : sg0;
                    float* yp = yout + ((size_t)(b * SEQ + t0)) * 1024 + h * 64 + half * 32 + rowi;
                    const long ystride = dir ? -1024 : 1024;
#pragma unroll 3
                    for (int step = 0; step < SC_T; ++step) {
                        scan_ld(c2, R, Vp, step + 2 < SC_T ? step + 2 : SC_T - 1);
                        scan_step(s2, c0);
                        f32x2 q0 = s2[0] * (f32x2){c0.r[0][0], c0.r[0][1]}, q1 = s2[2] * (f32x2){c0.r[1][0], c0.r[1][1]};
                        q0 = s2[1] * (f32x2){c0.r[0][2], c0.r[0][3]} + q0; q1 = s2[3] * (f32x2){c0.r[1][2], c0.r[1][3]} + q1;
                        q0 += q1;
                        const float qy = sum8(q0.x + q0.y);
                        yp[0] = qy; yp += ystride;
                        c0 = c1; c1 = c2;
                    }
                } else {
#pragma unroll 3
                    for (int step = 0; step < SC_T; ++step) {
                        scan_ld(c2, R, Vp, step + 2 < SC_T ? step + 2 : SC_T - 1);
                        scan_step(s2, c0);
                        c0 = c1; c1 = c2;
                    }
                }
                __builtin_amdgcn_s_setprio(0);
            }
            __syncthreads();
        }
    }
}


struct CombIn { u32x2 pw[3][3]; u32x2 afw, abw, gtw; f32x4 y0, y1; };
__device__ __forceinline__ void comb_load(CombIn& q, int task, int l16, const bf16_t* proj, const h16* af, const h16* ab, const h16* gate, const float* yf, const float* yb) {
    const int row = task >> 4, h = task & 15, ch = h * 64 + l16 * 4, t = row & (SEQ - 1);
    const bool hp = t > 0, hn = t < SEQ - 1;
    const bf16_t* pr = proj + (size_t)row * NP + ch;
    const u32x2 z2 = (u32x2){0u, 0u};
#pragma unroll
    for (int w = 0; w < 3; ++w) { q.pw[w][0] = hp ? *(const u32x2*)(pr - NP + w * 1024) : z2; q.pw[w][1] = *(const u32x2*)(pr + w * 1024); q.pw[w][2] = hn ? *(const u32x2*)(pr + NP + w * 1024) : z2; }
    q.afw = *(const u32x2*)(af + (size_t)row * 1024 + ch); q.abw = *(const u32x2*)(ab + (size_t)row * 1024 + ch); q.gtw = *(const u32x2*)(gate + (size_t)row * 1024 + ch);
    q.y0 = *(const f32x4*)(yf + (size_t)row * 1024 + ch); q.y1 = *(const f32x4*)(yb + (size_t)row * 1024 + ch);
}
struct CombPar { f32x4 ka, rk, gg, gb, c[3][3]; };
__device__ __forceinline__ void comb_params(CombPar& P, int h, int l16, const Params& p, const float* cw) {
    const int ch = h * 64 + l16 * 4;
    P.ka = *(const f32x4*)(p.in[I_KA] + ch); P.rk = *(const f32x4*)(p.in[I_RK] + ch); P.gg = *(const f32x4*)(p.in[I_GNG] + ch); P.gb = *(const f32x4*)(p.in[I_GNB] + ch);
#pragma unroll
    for (int w = 0; w < 3; ++w)
#pragma unroll
        for (int t = 0; t < 3; ++t) P.c[w][t] = *(const f32x4*)(cw + t * RW_COLS + w * 1024 + ch);
}
__device__ __forceinline__ void comb_compute(const CombIn& q, int task, int l16, const CombPar& P, bf16_t* O) {
    const int row = task >> 4, h = task & 15, ch = h * 64 + l16 * 4;
    const f32x4 ka = P.ka, rk = P.rk, gg = P.gg, gb = P.gb;
    f32x4 rkv[3];
#pragma unroll
    for (int w = 0; w < 3; ++w) {
        const f32x4 c0 = P.c[w][0], c1 = P.c[w][1], c2 = P.c[w][2];
#pragma unroll
        for (int i = 0; i < 4; ++i) {
            const float a = (i & 1) ? __uint_as_float(q.pw[w][0][i >> 1] & 0xffff0000u) : __uint_as_float(q.pw[w][0][i >> 1] << 16);
            const float b = (i & 1) ? __uint_as_float(q.pw[w][1][i >> 1] & 0xffff0000u) : __uint_as_float(q.pw[w][1][i >> 1] << 16);
            const float c = (i & 1) ? __uint_as_float(q.pw[w][2][i >> 1] & 0xffff0000u) : __uint_as_float(q.pw[w][2][i >> 1] << 16);
            rkv[w][i] = c0[i] * a + c1[i] * b + c2[i] * c;
        }
    }
    float bsum = 0.f, s0 = 0.f, s1 = 0.f;
    float gtv[4];
#pragma unroll
    for (int i = 0; i < 4; ++i) {
        const unsigned short ha = (unsigned short)((i & 1) ? (q.afw[i >> 1] >> 16) : (q.afw[i >> 1] & 0xffffu)), hb = (unsigned short)((i & 1) ? (q.abw[i >> 1] >> 16) : (q.abw[i >> 1] & 0xffffu)),
                             hg = (unsigned short)((i & 1) ? (q.gtw[i >> 1] >> 16) : (q.gtw[i >> 1] & 0xffffu));
        const float afv = (float)__builtin_bit_cast(h16, ha), abv = (float)__builtin_bit_cast(h16, hb); gtv[i] = (float)__builtin_bit_cast(h16, hg);
        const float khf = rkv[1][i] * (1.0f + (afv - 1.0f) * ka[i]), khb = rkv[1][i] * (1.0f + (abv - 1.0f) * ka[i]);
        bsum += rkv[0][i] * (khf + khb) * rk[i];
        s0 += q.y0[i]; s1 += q.y1[i];
    }
    bsum = sum16(bsum); s0 = sum16(s0) * (1.0f / 64.0f); s1 = sum16(s1) * (1.0f / 64.0f);
    float q0 = 0.f, q1 = 0.f;
    const f32x4 d0 = q.y0 - s0, d1 = q.y1 - s1;
#pragma unroll
    for (int i = 0; i < 4; ++i) { q0 += d0[i] * d0[i]; q1 += d1[i] * d1[i]; }
    const float r0 = __builtin_amdgcn_rsqf(sum16(q0) * (1.0f / 64.0f) + GN_EPS), r1 = __builtin_amdgcn_rsqf(sum16(q1) * (1.0f / 64.0f) + GN_EPS);
    float o[4];
#pragma unroll
    for (int i = 0; i < 4; ++i) o[i] = ((d0[i] * r0 + d1[i] * r1) * gg[i] + 2.0f * gb[i] + bsum * rkv[2][i]) * gtv[i];
    u32x2 w2; w2.x = cvt_pk_bf16(o[0], o[1]); w2.y = cvt_pk_bf16(o[2], o[3]);
    *(u32x2*)(O + (size_t)row * D + ch) = w2;
}

__device__ __forceinline__ void phase_combine(const Params& p, LAS unsigned char* lds) {
    const int tid = threadIdx.x, G = gridDim.x, bid = blockIdx.x, lane = tid & 63, wv = tid >> 6;
    const bf16_t* proj = (const bf16_t*)(p.ws + OFF_R5);
    const h16* lora = (const h16*)(p.ws + OFF_R6);
    const h16* af = lora + 2 * LORA_STRIDE; const h16* ab = lora + 3 * LORA_STRIDE; const h16* gate = lora + 4 * LORA_STRIDE;
    bf16_t* O = (bf16_t*)(p.ws + OFF_R6);
    const float* yf = p.out; const float* yb = p.out + (size_t)NTOK * 1024;
    const float* cw = p.in[I_CONVRW];
    {
        const int sub = lane >> 4, l16 = lane & 15;
        const int tstride = G * 32;
        CombPar par; comb_params(par, ((bid * 8 + wv) * 4 + sub) & 15, l16, p, cw);
        for (int task0 = (bid * 8 + wv) * 4 + sub; task0 < NTOK * 16; task0 += 2 * tstride) {
            CombIn in[2];
#pragma unroll
            for (int u = 0; u < 2; ++u) { const int task = task0 + u * tstride < NTOK * 16 ? task0 + u * tstride : task0; comb_load(in[u], task, l16, proj, af, ab, gate, yf, yb); }
#pragma unroll
            for (int u = 0; u < 2; ++u) {
                const int task = task0 + u * tstride;
                if (task < NTOK * 16) comb_compute(in[u], task, l16, par, O);
            }
        }
    }
    LAS float* tile = (LAS float*)lds;
    const bf16_t* yT = (const bf16_t*)(p.ws + OFF_R4);
    {
        const int cl = tid >> 3, ts = (tid & 7) * 8, tl = tid >> 3, cs = (tid & 7) * 8;
        u32x4 yw, nyw; u32x4 rx[3], nx[3];
        HyW W0; int ctw = -1;
        if (bid < 4096) { const int ct = bid & 15, tt = (bid >> 4) & 63, b = bid >> 10;
            yw = *(const u32x4*)(yT + ((size_t)(b * 1024 + ct * 64 + cl)) * SEQ + tt * 64 + ts);
            const int t = tt * 64 + tl; hy_raw3(proj + (size_t)(b * SEQ + t) * NP + RWP + ct * 64 + cs, t > 0, t < SEQ - 1, rx); }
        for (int u = bid; u < 4096; u += G) {
            const int ct = u & 15, tt = (u >> 4) & 63, b = u >> 10;
            { const int un = u + G < 4096 ? u + G : u; const int nct = un & 15, ntt = (un >> 4) & 63, nb = un >> 10;
              nyw = *(const u32x4*)(yT + ((size_t)(nb * 1024 + nct * 64 + cl)) * SEQ + ntt * 64 + ts);
              const int t = ntt * 64 + tl; hy_raw3(proj + (size_t)(nb * SEQ + t) * NP + RWP + nct * 64 + cs, t > 0, t < SEQ - 1, nx); }
            __syncthreads();
#pragma unroll
            for (int i = 0; i < 4; ++i) { tile[cl * 65 + ts + 2 * i] = __uint_as_float(yw[i] << 16); tile[cl * 65 + ts + 2 * i + 1] = __uint_as_float(yw[i] & 0xffff0000u); }
            __syncthreads();
            const int t = tt * 64 + tl, row = b * SEQ + t, c = ct * 64 + cs;
            float x0[8];
            if (ct != ctw) { hy_wload(W0, p.in[I_CONVHY], p.in[I_CONVHYB], 3072, c); ctw = ct; }
            hy_convw(rx, W0, x0);
            float o[8];
#pragma unroll
            for (int i = 0; i < 8; ++i) o[i] = tile[(cs + i) * 65 + tl] * x0[i];
            u32x4 w; w.x = cvt_pk_bf16(o[0], o[1]); w.y = cvt_pk_bf16(o[2], o[3]); w.z = cvt_pk_bf16(o[4], o[5]); w.w = cvt_pk_bf16(o[6], o[7]);
            *(u32x4*)(O + (size_t)row * D + 1024 + c) = w;
            yw = nyw;
#pragma unroll
            for (int i = 0; i < 3; ++i) rx[i] = nx[i];
        }
    }
}

__device__ __forceinline__ void phase_ffn_weights(const Params& p, LAS unsigned char* lds) {
    LAS float* tile = (LAS float*)lds;
    bf16_t* W13T = (bf16_t*)(p.ws + OFF_R5); bf16_t* W2T = (bf16_t*)(p.ws + OFF_R5 + 44 * MBy);
    const int n13 = 32 * 22, n2 = 88 * 8;
    for (int u = blockIdx.x; u < 2 * n13 + n2; u += gridDim.x) {
        if (u < n13) tr_tile(tile, p.in[I_FFW1], DFF, (u & 31) * 64, (u >> 5) * TRN, W13T, D, MapFF{0});
        else if (u < 2 * n13) { const int v = u - n13; tr_tile(tile, p.in[I_FFW3], DFF, (v & 31) * 64, (v >> 5) * TRN, W13T, D, MapFF{128}); }
        else { const int v = u - 2 * n13; tr_tile(tile, p.in[I_FFW2], D, (v % 88) * 64, (v / 88) * TRN, W2T, DFF, MapId()); }
    }
    __syncthreads();
}

template <int MODE> struct LnRow;
template <> struct LnRow<0> { f32x4 r[8]; u32x2 s[8]; };
template <> struct LnRow<1> { u32x2 r[8]; u32x2 s[8]; };
__device__ __forceinline__ f32x4 bf4(u32x2 w) { return (f32x4){__uint_as_float(w.x << 16), __uint_as_float(w.x & 0xffff0000u), __uint_as_float(w.y << 16), __uint_as_float(w.y & 0xffff0000u)}; }
__device__ __forceinline__ void ln_load(LnRow<0>& q, const void* resid, const bf16_t* small, int row, int lane) {
#pragma unroll
    for (int i = 0; i < 8; ++i) { q.r[i] = *(const f32x4*)((const float*)resid + (size_t)row * D + i * 256 + lane * 4); q.s[i] = *(const u32x2*)(small + (size_t)row * D + i * 256 + lane * 4); }
}
__device__ __forceinline__ void ln_load(LnRow<1>& q, const void* resid, const bf16_t* small, int row, int lane) {
#pragma unroll
    for (int i = 0; i < 8; ++i) { q.r[i] = *(const u32x2*)((const bf16_t*)resid + (size_t)row * D + i * 256 + lane * 4); q.s[i] = *(const u32x2*)(small + (size_t)row * D + i * 256 + lane * 4); }
}
__device__ __forceinline__ f32x4 ln_resid(const LnRow<0>& q, int i) { return q.r[i]; }
__device__ __forceinline__ f32x4 ln_resid(const LnRow<1>& q, int i) { return bf4(q.r[i]); }
template <int MODE>
__device__ __forceinline__ void phase_ln(const Params& p, LAS unsigned char* lds, const void* resid, const bf16_t* small, int gate_idx, float* dst, bf16_t* X1, bf16_t* U, const float* g, const float* bta) {
    const int lane = threadIdx.x & 63, wv = threadIdx.x >> 6;
    const float* mod = (const float*)(p.ws + OFF_MOD); const float* pe = (const float*)(p.ws + OFF_PE);
    LAS float* PL = (LAS float*)lds;
    constexpr int NPB = MODE == 0 ? 3 : 1, NARR = 2 + 4 * NPB;
    __syncthreads();
    for (int i = threadIdx.x; i < NARR * (D / 4); i += NTHREADS) {
        const int arr = i >> 9, c = (i & 511) * 4;
        const float* srcp = arr == 0 ? g + c : arr == 1 ? bta + c : mod + (size_t)((arr - 2) / NPB) * 6 * D + (MODE == 0 ? 2 + (arr - 2) % NPB : gate_idx) * D + c;
        *(LAS f32x4*)(PL + arr * D + c) = *(const f32x4*)srcp;
    }
    __syncthreads();
    const int stride = gridDim.x * 8;
    int row = blockIdx.x * 8 + wv;
    LnRow<MODE> cur, nxt;
    if (row < NTOK) ln_load(cur, resid, small, row, lane);
    for (; row < NTOK; row += stride) {
        const int rn = row + stride < NTOK ? row + stride : row;
        ln_load(nxt, resid, small, rn, lane);
        const int b = row >> 12, t = row & 4095;
        f32x4 v[8];
        float s = 0.f;
#pragma unroll
        for (int i = 0; i < 8; ++i) { const int c = i * 256 + lane * 4;
            f32x4 rs = ln_resid(cur, i);
            if (MODE == 0) { const float* pp = c < 1024 ? pe + (t >> 6) * 1024 + c : pe + (t & 63) * 1024 + (c - 1024); rs += *(const f32x4*)pp; }
            const f32x4 gv = *(const LAS f32x4*)(PL + (2 + b * NPB) * D + c);
            v[i] = rs * ALPHA + gv * bf4(cur.s[i]);
            s += (v[i][0] + v[i][1]) + (v[i][2] + v[i][3]); }
        const float mu = wave_sum(s) * (1.0f / D);
        float q = 0.f;
#pragma unroll
        for (int i = 0; i < 8; ++i) { v[i] -= mu; q += (v[i][0] * v[i][0] + v[i][1] * v[i][1]) + (v[i][2] * v[i][2] + v[i][3] * v[i][3]); }
        const float rs_ = __builtin_amdgcn_rsqf(wave_sum(q) * (1.0f / D) + LN_EPS);
#pragma unroll
        for (int i = 0; i < 8; ++i) { const int c = i * 256 + lane * 4;
            const f32x4 o = v[i] * rs_ * *(const LAS f32x4*)(PL + c) + *(const LAS f32x4*)(PL + D + c);
            if (MODE == 1) *(f32x4*)(dst + (size_t)row * D + c) = o;
            if (MODE == 0) { u32x2 xw; xw.x = cvt_pk_bf16(o[0], o[1]); xw.y = cvt_pk_bf16(o[2], o[3]); *(u32x2*)(X1 + (size_t)row * D + c) = xw;
                const f32x4 sh = *(const LAS f32x4*)(PL + (2 + b * NPB + 1) * D + c), sc = *(const LAS f32x4*)(PL + (2 + b * NPB + 2) * D + c);
                const f32x4 m = o * (sc + 1.0f) + sh; u32x2 w; w.x = cvt_pk_bf16(m[0], m[1]); w.y = cvt_pk_bf16(m[2], m[3]); *(u32x2*)(U + (size_t)row * D + c) = w; } }
        cur = nxt;
    }
}

constexpr int N_PHASES = 13;
#ifndef SYNC_REPS
#define SYNC_REPS 1
#endif
#ifndef DUP_MASK
#define DUP_MASK 0
#endif
#define gsync() do { XcdBarrier _gb; _gb.bar = (unsigned*)(p.ws + OFF_BAR); _gb.x = xb_xcc_id(); _gb.st = (volatile LAS unsigned*)(lds + 131072); for (int _r = 0; _r < SYNC_REPS; ++_r) xcd_barrier(_gb); } while (0)
#ifndef ONLY_PHASE
#define PH_ON(n) true
#else
#define PH_ON(n) ((n) == ONLY_PHASE)
#endif
__global__ void __launch_bounds__(NTHREADS) fwd_mega(Params p) {
    extern __shared__ __attribute__((aligned(16))) unsigned char lds_raw[];
    LAS unsigned char* lds = (LAS unsigned char*)lds_raw;
    unsigned char* ws = p.ws;
    const int G = gridDim.x;
    volatile LAS unsigned* bst = (volatile LAS unsigned*)(lds + 131072);
    if (threadIdx.x < 4) bst[threadIdx.x] = 0u;
    __syncthreads();
    (void)xcd_barrier_post((unsigned*)(ws + OFF_BAR), bst);
    if (p.ph_hi > 1000) cg::this_grid().sync();
    if (PH_ON(0) && p.ph_lo <= 0 && 0 < p.ph_hi) { if (0 > p.ph_lo) gsync();
      for (int rep = 0; rep < (((DUP_MASK >> 0) & 1) ? 2 : 1); ++rep) { if (rep) gsync();
        phase_prep(p, lds);
      }
    }
    if (PH_ON(1) && p.ph_lo <= 1 && 1 < p.ph_hi) { if (1 > p.ph_lo) gsync();
      for (int rep = 0; rep < (((DUP_MASK >> 1) & 1) ? 2 : 1); ++rep) { if (rep) gsync();
        phase_modfin(p);
      }
    }
    if (PH_ON(2) && p.ph_lo <= 2 && 2 < p.ph_hi) { if (2 > p.ph_lo) gsync();
      for (int rep = 0; rep < (((DUP_MASK >> 2) & 1) ? 2 : 1); ++rep) { if (rep) gsync();
        phase_a1(p);
      }
    }
    if (PH_ON(3) && p.ph_lo <= 3 && 3 < p.ph_hi) { if (3 > p.ph_lo) gsync();
      for (int rep = 0; rep < (((DUP_MASK >> 3) & 1) ? 2 : 1); ++rep) { if (rep) gsync();
        {
                  { pg8::Gemm g{(const bf16_t*)(ws + OFF_R4), (const bf16_t*)(ws + OFF_R1), NTOK, NP, D}; pg8::StaticOrder S; S.init(NTOK, NP, G, blockIdx.x);
                    EpiProj E{(bf16_t*)(ws + OFF_R5), NP}; pg8::gemm_phase(lds, g, S, E); }
                  { pg8::Gemm g{(const bf16_t*)(ws + OFF_R4) + (size_t)NTOK * D, (const bf16_t*)(ws + OFF_R1), NCTX, RWP, D}; pg8::StaticOrder S; S.init(NCTX, RWP, G, (blockIdx.x + G / 2) % G);
                    EpiProj E{(bf16_t*)(ws + OFF_R5) + (size_t)NTOK * NP, NP}; pg8::gemm_phase(lds, g, S, E); } }
      }
    }
    if (PH_ON(4) && p.ph_lo <= 4 && 4 < p.ph_hi) { if (4 > p.ph_lo) gsync();
      for (int rep = 0; rep < (((DUP_MASK >> 4) & 1) ? 2 : 1); ++rep) { if (rep) gsync();
        phase_post_proj(p, lds);
      }
    }
    if (PH_ON(5) && p.ph_lo <= 5 && 5 < p.ph_hi) { if (5 > p.ph_lo) gsync();
      for (int rep = 0; rep < (((DUP_MASK >> 5) & 1) ? 2 : 1); ++rep) { if (rep) gsync();
        { pg8::Gemm g{(const bf16_t*)(ws + OFF_R1), (const bf16_t*)(ws + OFF_BT2), MROWS, NL, KL + (p.ph_hi >> 20) * 128}; pg8::StaticOrder S; S.init(MROWS, NL, G, blockIdx.x);
                  EpiLora E{(h16*)(ws + OFF_R6), (const float*)(ws + OFF_LB)};
#ifndef NO_LGEMM
                  pg8::gemm_phase(lds, g, S, E);
#endif

#ifndef NO_FFT
                  phase_hyena_fft(p, lds);
#endif
                  }
      }
    }
    if (PH_ON(6) && p.ph_lo <= 6 && 6 < p.ph_hi) { if (6 > p.ph_lo) gsync();
      for (int rep = 0; rep < (((DUP_MASK >> 6) & 1) ? 2 : 1); ++rep) { if (rep) gsync();
        phase_scan(p, lds);
      }
    }
    if (PH_ON(7) && p.ph_lo <= 7 && 7 < p.ph_hi) { if (7 > p.ph_lo) gsync();
      for (int rep = 0; rep < (((DUP_MASK >> 7) & 1) ? 2 : 1); ++rep) { if (rep) gsync();
        phase_combine(p, lds);
      }
    }
    if (PH_ON(8) && p.ph_lo <= 8 && 8 < p.ph_hi) { if (8 > p.ph_lo) gsync();
      for (int rep = 0; rep < (((DUP_MASK >> 8) & 1) ? 2 : 1); ++rep) { if (rep) gsync();
        {
                  pg8::Gemm g{(const bf16_t*)(ws + OFF_R6), (const bf16_t*)(ws + OFF_WOUT), NTOK, D, D}; pg8::StaticOrder S; S.init(NTOK, D, G, blockIdx.x);
                  EpiProj E{(bf16_t*)p.out, D}; pg8::gemm_phase(lds, g, S, E); }
      }
    }
    if (PH_ON(9) && p.ph_lo <= 9 && 9 < p.ph_hi) { if (9 > p.ph_lo) gsync();
      for (int rep = 0; rep < (((DUP_MASK >> 9) & 1) ? 2 : 1); ++rep) { if (rep) gsync();
        { phase_ffn_weights(p, lds); phase_ln<0>(p, lds, p.in[I_X], (const bf16_t*)p.out, 2, nullptr, (bf16_t*)(ws + OFF_R5 + 66 * MBy), (bf16_t*)(ws + OFF_R4), p.in[I_LN1G], p.in[I_LN1B]); }
      }
    }
    if (PH_ON(10) && p.ph_lo <= 10 && 10 < p.ph_hi) { if (10 > p.ph_lo) gsync();
      for (int rep = 0; rep < (((DUP_MASK >> 10) & 1) ? 2 : 1); ++rep) { if (rep) gsync();
        { pg8::Gemm g{(const bf16_t*)(ws + OFF_R4), (const bf16_t*)(ws + OFF_R5), NTOK, 2 * DFF, D}; pg8::StaticOrder S; S.init(NTOK, 2 * DFF, G, blockIdx.x);
                   EpiSwiglu E{(bf16_t*)(ws + OFF_R1)}; pg8::gemm_phase(lds, g, S, E); }
      }
    }
    if (PH_ON(11) && p.ph_lo <= 11 && 11 < p.ph_hi) { if (11 > p.ph_lo) gsync();
      for (int rep = 0; rep < (((DUP_MASK >> 11) & 1) ? 2 : 1); ++rep) { if (rep) gsync();
        { pg8::Gemm g{(const bf16_t*)(ws + OFF_R1), (const bf16_t*)(ws + OFF_R5 + 44 * MBy), NTOK, D, DFF}; pg8::StaticOrder S; S.init(NTOK, D, G, blockIdx.x);
                   EpiProj E{(bf16_t*)(ws + OFF_R4), D}; pg8::gemm_phase(lds, g, S, E); }
      }
    }
    if (PH_ON(12) && p.ph_lo <= 12 && 12 < p.ph_hi) { if (12 > p.ph_lo) gsync();
      for (int rep = 0; rep < (((DUP_MASK >> 12) & 1) ? 2 : 1); ++rep) { if (rep) gsync();
        phase_ln<1>(p, lds, (const void*)(ws + OFF_R5 + 66 * MBy), (const bf16_t*)(ws + OFF_R4), 5, p.out, nullptr, nullptr, p.in[I_LN2G], p.in[I_LN2B]);
      }
    }
}

#ifndef N_LAUNCH_SPLIT
#define N_LAUNCH_SPLIT 1
#endif
extern "C" void kernel_launch(void* const* d_in, const int* in_sizes, int n_in, void* d_out, int out_size, void* d_ws, size_t ws_size, hipStream_t stream) {
    static int grid = 0;
    if (grid == 0) {
        if (n_in != 39 || ws_size < WS_END || out_size != NTOK * D) { fprintf(stderr, "kernel_launch: unexpected shapes (n_in %d, ws %zu, out %d)\n", n_in, ws_size, out_size); grid = -1; return; }
        int dev = 0, cus = 0, per_cu = 0;
        hipGetDevice(&dev); hipDeviceGetAttribute(&cus, hipDeviceAttributeMultiprocessorCount, dev);
        if (hipFuncSetAttribute((const void*)fwd_mega, hipFuncAttributeMaxDynamicSharedMemorySize, LDS_BYTES) != hipSuccess) { fprintf(stderr, "kernel_launch: hipFuncSetAttribute failed\n"); grid = -1; return; }
        if (hipOccupancyMaxActiveBlocksPerMultiprocessor(&per_cu, (const void*)fwd_mega, NTHREADS, LDS_BYTES) != hipSuccess || per_cu < 1) { fprintf(stderr, "kernel_launch: occupancy query gives %d\n", per_cu); per_cu = 1; }
        (void)hipGetLastError();
        grid = cus * 1;
        if (grid <= 0) grid = 256;
    }
    if (grid < 0) return;
    if (hipMemsetAsync((char*)d_ws + OFF_BAR, 0, XCD_BAR_WORDS * 4, stream) != hipSuccess) { fprintf(stderr, "kernel_launch: memset of barrier words failed\n"); return; }
    Params p{};
    for (int i = 0; i < 39; ++i) p.in[i] = (const float*)d_in[i];
    p.out = (float*)d_out; p.ws = (unsigned char*)d_ws;
#if N_LAUNCH_SPLIT
    p.ph_lo = 0; p.ph_hi = N_PHASES;
    void* args[] = {&p};
    hipError_t e = hipLaunchCooperativeKernel((const void*)fwd_mega, dim3(grid), dim3(NTHREADS), args, LDS_BYTES, stream);
    if (e != hipSuccess) fprintf(stderr, "cooperative launch failed: %s (grid %d)\n", hipGetErrorString(e), grid);
#else
    for (int ph = 0; ph < N_PHASES; ++ph) { p.ph_lo = ph; p.ph_hi = ph + 1; hipLaunchKernelGGL(fwd_mega, dim3(grid), dim3(NTHREADS), LDS_BYTES, stream, p); }
#endif
}
```

```cpp
#include <hip/hip_runtime.h>
#include <hip/hip_cooperative_groups.h>
#include <cstdio>
#include <cstdint>
namespace cg = cooperative_groups;

#define LAS __attribute__((address_space(3)))
typedef unsigned short bf16_t;
typedef short bf16x8 __attribute__((ext_vector_type(8)));
typedef float f32x4 __attribute__((ext_vector_type(4)));
typedef float f32x2 __attribute__((ext_vector_type(2)));
typedef unsigned u32x4 __attribute__((ext_vector_type(4)));
typedef unsigned u32x2 __attribute__((ext_vector_type(2)));
typedef _Float16 h16;
typedef _Float16 h16x8 __attribute__((ext_vector_type(8)));

constexpr int D = 2048, NB = 4, SEQ = 4096, NTOK = NB * SEQ, CTX = 256, NCTX = NB * CTX, MROWS = NTOK + NCTX;
constexpr int RW = 1024, RW_COLS = 3360, RWP = 3584, HY = 1024, NP = 6656, IN_COLS = 6432, DFF = 5632;
constexpr int KL = 384, NL = 5120;
constexpr float ALPHA = 1.189207115f;
constexpr float LN_EPS = 1e-5f, GN_EPS = 64e-5f;
constexpr size_t MBy = 1u << 20;
constexpr size_t OFF_MOD = 0, OFF_MODP = 256 * 1024, OFF_PE = OFF_MODP + 7680 * 1024, OFF_H2 = 8 * MBy, OFF_LB = 9 * MBy, OFF_BAR = 9 * MBy + 512 * 1024, OFF_WOUT = 10 * MBy, OFF_BT2 = 18 * MBy,
                 OFF_R1 = 22 * MBy, OFF_R6 = 48 * MBy, OFF_R4 = 216 * MBy, OFF_R5 = 284 * MBy, WS_END = 505 * MBy;
constexpr size_t LORA_STRIDE = (size_t)MROWS * 1024;
constexpr int LDS_BYTES = 131072 + 16;
constexpr int NTHREADS = 512;

struct Params { const float* in[39]; float* out; unsigned char* ws; int ph_lo, ph_hi; };

enum { I_X = 0, I_C, I_CTX, I_CCTX, I_WADA, I_BADA, I_WIN, I_CONVRW, I_CONVHY, I_CONVHYB, I_W0F, I_WUPF, I_A0F, I_AUPF, I_W0B, I_WUPB, I_A0B, I_AUPB,
       I_KK, I_KA, I_RK, I_GUP, I_GNG, I_GNB, I_FW1, I_FB1, I_FW2, I_FB2, I_FW3, I_SINF, I_HYB, I_WOUT, I_LN1G, I_LN1B, I_FFW1, I_FFW3, I_FFW2, I_LN2G, I_LN2B };

__device__ __forceinline__ unsigned cvt_pk_bf16(float lo, float hi) { unsigned r; asm volatile("v_cvt_pk_bf16_f32 %0, %1, %2" : "=v"(r) : "v"(lo), "v"(hi)); return r; }
__device__ __forceinline__ float bf2f(unsigned short v) { return __uint_as_float(((unsigned)v) << 16); }
__device__ __forceinline__ float sigmoidf_(float x) { return __builtin_amdgcn_rcpf(1.0f + __expf(-x)); }
__device__ __forceinline__ float wave_sum(float v) {
#pragma unroll
    for (int o = 32; o >= 1; o >>= 1) v += __shfl_xor(v, o);
    return v;
}
template <int CTRL> __device__ __forceinline__ float dpp_f(float v) { return __int_as_float(__builtin_amdgcn_update_dpp(0, __float_as_int(v), CTRL, 0xf, 0xf, true)); }
__device__ __forceinline__ float sum16(float v) { v += dpp_f<0xB1>(v); v += dpp_f<0x4E>(v); v += dpp_f<0x141>(v); v += dpp_f<0x140>(v); return v; }
__device__ __forceinline__ float sum8(float v) { v += dpp_f<0xB1>(v); v += dpp_f<0x4E>(v); v += dpp_f<0x141>(v); return v; }


#define XB_TMO      128
#define XB_XCNT(j)  (256  + 64 * (j))
#define XB_XSUB(j)  (1280 + 64 * (j))
#define XB_XGEN(j)  (2304 + 64 * (j))
#define XB_TOP      3328
#define XB_TOPGEN   3392
#define XCD_BAR_WORDS 3456
#define XB_SPIN_CAP (1u << 18)
__device__ __forceinline__ unsigned xb_ld(unsigned* p)              { return __hip_atomic_load(p, __ATOMIC_RELAXED, __HIP_MEMORY_SCOPE_AGENT); }
__device__ __forceinline__ unsigned xb_add(unsigned* p, unsigned v) { return __hip_atomic_fetch_add(p, v, __ATOMIC_RELAXED, __HIP_MEMORY_SCOPE_AGENT); }
__device__ __forceinline__ unsigned xb_xcc_id() { return (unsigned)__builtin_amdgcn_s_getreg((3 << 11) | 20) & 0xFu; }
#define XB_SPIN(cond, bar) do { unsigned _sp = 0; while (cond) { __builtin_amdgcn_s_sleep(1); \
    if ((++_sp & 255u) == 0u) { if (xb_ld(&(bar)[XB_TMO])) break; if (_sp > XB_SPIN_CAP) { atomicAdd(&(bar)[XB_TMO], 1u); break; } } } } while (0)
struct XcdBarrier { unsigned* bar; unsigned x; volatile LAS unsigned* st; };
__device__ __forceinline__ XcdBarrier xcd_barrier_post(unsigned* bar, volatile LAS unsigned* st) {
    XcdBarrier b; b.bar = bar; b.x = xb_xcc_id(); b.st = st;
    if (threadIdx.x == 0) (void)xb_add(&bar[XB_XCNT(b.x)], 1u);
    return b;
}
__device__ __forceinline__ void xcd_barrier_complete(unsigned* bar, unsigned x, unsigned& nloc, unsigned& nx) {
    const unsigned G = gridDim.x * gridDim.y * gridDim.z;
    unsigned sum, cnt, mine, sp = 0u;
    for (;;) {
        sum = 0u; cnt = 0u; mine = 0u;
#pragma unroll
        for (unsigned j = 0; j < 16; ++j) { const unsigned c = xb_ld(&bar[XB_XCNT(j)]); sum += c; cnt += (c > 0u) ? 1u : 0u; mine = (j == x) ? c : mine; }
        if (sum == G) break;
        __builtin_amdgcn_s_sleep(1);
        if ((++sp & 255u) == 0u) { if (xb_ld(&bar[XB_TMO])) break; if (sp > XB_SPIN_CAP) { atomicAdd(&bar[XB_TMO], 1u); break; } }
    }
    nloc = mine > 0u ? mine : 1u; nx = cnt > 0u ? cnt : 1u;
}
__device__ __forceinline__ void xcd_barrier(const XcdBarrier& b) {
    asm volatile("s_waitcnt vmcnt(0)" ::: "memory");
    __syncthreads();
    if (threadIdx.x == 0) {
        unsigned* bar = b.bar;
        __builtin_amdgcn_s_waitcnt(0);
        unsigned nloc = b.st[0], nx = b.st[1];
        if (nloc == 0u) { xcd_barrier_complete(bar, b.x, nloc, nx); b.st[0] = nloc; b.st[1] = nx; }
        const unsigned old = xb_add(&bar[XB_XSUB(b.x)], 1u);
        const unsigned gen = old / nloc;
        if (old + 1u == (gen + 1u) * nloc) {
            __builtin_amdgcn_fence(__ATOMIC_RELEASE, "agent");
            asm volatile("s_waitcnt vmcnt(0)" ::: "memory");
            const unsigned og = xb_add(&bar[XB_TOP], 1u);
            const unsigned tg = og / nx;
            if (og + 1u == (tg + 1u) * nx) xb_add(&bar[XB_TOPGEN], 1u);
            else XB_SPIN(xb_ld(&bar[XB_TOPGEN]) == tg, bar);
            __builtin_amdgcn_fence(__ATOMIC_ACQUIRE, "agent");
            xb_add(&bar[XB_XGEN(b.x)], 1u);
            asm volatile("s_waitcnt vmcnt(0)" ::: "memory");
        } else {
            XB_SPIN(xb_ld(&bar[XB_XGEN(b.x)]) == gen, bar);
            __builtin_amdgcn_fence(__ATOMIC_ACQUIRE, "agent");
            asm volatile("s_waitcnt vmcnt(0)" ::: "memory");
        }
    }
    __syncthreads();
}

namespace pg8 {
constexpr int BM = 256, BK = 64, HALF = 128, HTB = HALF * BK * 2, STAGE_BYTES = 8 * HTB, NXCD = 8, WGM = 8;
__host__ __device__ __forceinline__ int lds_byte(int r, int c) { const int st = (r >> 4) * 2 + (c >> 5), rr = r & 15, cc = c & 31, ob = rr * 64 + cc * 2; return st * 1024 + (ob ^ (((ob >> 9) & 1) << 5)); }
__host__ __device__ __forceinline__ void stage_rc(int b, int& R, int& C) { const int st = b / 1024, sb = b % 1024, swz = sb ^ (((sb >> 9) & 1) << 5); R = (st >> 1) * 16 + swz / 64; C = (st & 1) * 32 + (swz % 64) / 2; }
__host__ __device__ __forceinline__ int perm32(int rho) { const int n = rho >> 4, i = rho & 15; return 8 * (i >> 2) + 4 * n + (i & 3); }
struct Unit { int pm, pn; };
struct Gemm { const bf16_t* A; const bf16_t* Bt; int M, N, K; };
struct StaticOrder {
    int nM, nN, nwg, G, c;
    __host__ __device__ void init(int M, int N, int G_, int c_) { nM = M / BM; nN = N / BM; nwg = nM * nN; G = G_; c = c_; }
    __host__ __device__ bool next(int i, Unit& u) const {
        const long L = (long)i * G + c; if (L >= nwg) return false;
        int wgid = (int)L; { const int q = nwg / NXCD, r = nwg % NXCD, xcd = wgid % NXCD, off = wgid / NXCD; wgid = (xcd < r ? xcd * (q + 1) : r * (q + 1) + (xcd - r) * q) + off; }
        const int nig = WGM * nN, gid = wgid / nig, fm = gid * WGM, gsz = (nM - fm) < WGM ? (nM - fm) : WGM;
        u.pm = fm + ((wgid % nig) % gsz); u.pn = (wgid % nig) / gsz; return true;
    }
    __device__ __forceinline__ void a_ready(const Unit&) const {}
    __device__ __forceinline__ void done(const Unit&) const {}
};

template <class Epi, class Sched>
__device__ __forceinline__ void gemm_phase(LAS unsigned char* lds, const Gemm g, const Sched& S, const Epi& E) {
    const int tid = threadIdx.x, wid = __builtin_amdgcn_readfirstlane(tid >> 6), lane = tid & 63, wr = wid >> 2, wc = wid & 3, fr = lane & 15, fq = lane >> 4;
    const int K = g.K, nt = K / BK;
    unsigned voffA[2], voffB[2];
#pragma unroll
    for (int i = 0; i < 2; ++i) { int R, C; stage_rc(tid * 16 + i * 8192, R, C); const int Rb = Epi::PERM ? ((R & ~31) + perm32(R & 31)) : R;
        voffA[i] = (unsigned)(R * K + C) * 2u; voffB[i] = (unsigned)(Rb * K + C) * 2u; }
    const size_t kstep = (size_t)(BK * 2);
    const size_t hstep = (size_t)HALF * K * 2;
    const size_t tstep = 2 * hstep;
    const unsigned ldsw = (unsigned)wid * 1024u;
    const int aoff = lds_byte(wr * 64 + fr, fq * 8), boff = lds_byte(wc * 32 + fr, fq * 8);
#define PG8_SA(b, h) (((b) * 2 + (h)) * HTB)
#define PG8_SB(b, h) ((4 + (b) * 2 + (h)) * HTB)
#define PG8_STAGE(bufoff, gbase, voff) do { _Pragma("unroll") for (int _i = 0; _i < 2; ++_i) \
        __builtin_amdgcn_global_load_lds((const unsigned*)((const char*)(gbase) + (voff)[_i]), (LAS unsigned*)(lds + (bufoff) + ldsw + _i * 8192), 16, 0, 0); } while (0)
#define PG8_LDA(dst, b, h) do { _Pragma("unroll") for (int m = 0; m < 4; ++m) _Pragma("unroll") for (int k = 0; k < 2; ++k) dst[m][k] = *(const LAS bf16x8*)(lds + PG8_SA(b, h) + aoff + m * 2048 + k * 1024); } while (0)
#define PG8_LDB(dst, b, h) do { _Pragma("unroll") for (int n = 0; n < 2; ++n) _Pragma("unroll") for (int k = 0; k < 2; ++k) dst[n][k] = *(const LAS bf16x8*)(lds + PG8_SB(b, h) + boff + n * 2048 + k * 1024); } while (0)
#define PG8_MMA(ai, bj, At, Bt) do { __builtin_amdgcn_s_setprio(1); _Pragma("unroll") for (int m = 0; m < 4; ++m) _Pragma("unroll") for (int n = 0; n < 2; ++n) _Pragma("unroll") for (int k = 0; k < 2; ++k) \
        acc[ai][bj][m][n] = __builtin_amdgcn_mfma_f32_16x16x32_bf16(Bt[n][k], At[m][k], acc[ai][bj][m][n], 0, 0, 0); __builtin_amdgcn_s_setprio(0); } while (0)
#define PG8_WAIT_V(n) asm volatile("s_waitcnt vmcnt(" #n ")" ::: "memory")
#define PG8_WAIT_L(n) asm volatile("s_waitcnt lgkmcnt(" #n ")" ::: "memory")
#define PG8_BAR __builtin_amdgcn_s_barrier()
#define PG8_SCHED __builtin_amdgcn_sched_barrier(0)
    Unit cur, nxt; int ui = 0;
    if (!S.next(0, cur)) return;
    f32x4 acc[2][2][4][2];
#pragma unroll
    for (int a = 0; a < 2; ++a)
#pragma unroll
        for (int b = 0; b < 2; ++b)
#pragma unroll
            for (int m = 0; m < 4; ++m)
#pragma unroll
                for (int n = 0; n < 2; ++n) acc[a][b][m][n] = (f32x4){0.f, 0.f, 0.f, 0.f};
    bf16x8 At[4][2], B0[2][2], B1[2][2];
    const char* cA = (const char*)g.A + (size_t)cur.pm * tstep; const char* cB = (const char*)g.Bt + (size_t)cur.pn * tstep;
    S.a_ready(cur);
    PG8_STAGE(PG8_SB(0, 0), cB, voffB); PG8_STAGE(PG8_SB(0, 1), cB + hstep, voffB); PG8_STAGE(PG8_SA(0, 0), cA, voffA); PG8_STAGE(PG8_SA(0, 1), cA + hstep, voffA);
    if (wr == 1) PG8_BAR;
    PG8_WAIT_V(2); PG8_BAR;
    PG8_STAGE(PG8_SB(1, 0), cB + kstep, voffB); PG8_STAGE(PG8_SA(1, 0), cA + kstep, voffA); PG8_STAGE(PG8_SB(1, 1), cB + hstep + kstep, voffB);
    PG8_WAIT_V(6); PG8_BAR;
    for (;;) {
        const bool has_next = S.next(ui + 1, nxt);
        const char* nA = has_next ? (const char*)g.A + (size_t)nxt.pm * tstep : cA; const char* nB = has_next ? (const char*)g.Bt + (size_t)nxt.pn * tstep : cB;
        for (int t = 0; t < nt; t += 2) {
            const bool last = (t == nt - 2);
            const char* a1 = cA + (size_t)(t + 1) * kstep;
            const char* a2 = last ? nA : cA + (size_t)(t + 2) * kstep; const char* b2 = last ? nB : cB + (size_t)(t + 2) * kstep;
            const char* a3 = a2 + kstep; const char* b3 = b2 + kstep;
            if (last && has_next) S.a_ready(nxt);
            PG8_LDB(B0, 0, 0); PG8_LDB(B1, 0, 1); PG8_SCHED; PG8_LDA(At, 0, 0); PG8_STAGE(PG8_SA(1, 1), a1 + hstep, voffA);
            PG8_WAIT_V(8); PG8_WAIT_L(0); PG8_BAR; PG8_MMA(0, 0, At, B0); PG8_MMA(0, 1, At, B1); PG8_BAR; PG8_SCHED;
            PG8_LDA(At, 0, 1); PG8_STAGE(PG8_SB(0, 0), b2, voffB); PG8_STAGE(PG8_SB(0, 1), b2 + hstep, voffB); PG8_STAGE(PG8_SA(0, 0), a2, voffA);
            PG8_WAIT_V(8); PG8_WAIT_L(0); PG8_BAR; PG8_MMA(1, 0, At, B0); PG8_MMA(1, 1, At, B1); PG8_BAR; PG8_SCHED;
            PG8_LDB(B0, 1, 0); PG8_LDB(B1, 1, 1); PG8_SCHED; PG8_LDA(At, 1, 0); PG8_STAGE(PG8_SA(0, 1), a2 + hstep, voffA);
            PG8_WAIT_V(8); PG8_WAIT_L(0); PG8_BAR; PG8_MMA(0, 0, At, B0); PG8_MMA(0, 1, At, B1); PG8_BAR; PG8_SCHED;
            PG8_LDA(At, 1, 1); PG8_STAGE(PG8_SB(1, 0), b3, voffB); PG8_STAGE(PG8_SB(1, 1), b3 + hstep, voffB); PG8_STAGE(PG8_SA(1, 0), a3, voffA);
            PG8_WAIT_V(8); PG8_WAIT_L(0); PG8_BAR; PG8_MMA(1, 0, At, B0); PG8_MMA(1, 1, At, B1); PG8_BAR; PG8_SCHED;
        }
        if (wr == 0) PG8_BAR;
        E(acc, cur, wr, wc, fr, fq); S.done(cur);
        if (!has_next) break;
#pragma unroll
        for (int a = 0; a < 2; ++a)
#pragma unroll
            for (int b = 0; b < 2; ++b)
#pragma unroll
                for (int m = 0; m < 4; ++m)
#pragma unroll
                    for (int n = 0; n < 2; ++n) acc[a][b][m][n] = (f32x4){0.f, 0.f, 0.f, 0.f};
        cur = nxt; cA = nA; cB = nB; ++ui;
        if (wr == 1) PG8_BAR;
    }
    PG8_WAIT_V(0);
    PG8_BAR;
#undef PG8_SA
#undef PG8_SB
#undef PG8_STAGE
#undef PG8_LDA
#undef PG8_LDB
#undef PG8_MMA
#undef PG8_WAIT_V
#undef PG8_WAIT_L
#undef PG8_BAR
#undef PG8_SCHED
}
}
using pg8::Unit;

__device__ __forceinline__ float pos_emb(const float* pe, int t, int d) { return d < 1024 ? pe[(t >> 6) * 1024 + d] : pe[(t & 63) * 1024 + (d - 1024)]; }

struct EpiProj {
    static constexpr bool PERM = true;
    bf16_t* O; int ldc;
    __device__ __forceinline__ void operator()(const f32x4 (&acc)[2][2][4][2], const Unit& u, int wr, int wc, int fr, int fq) const {
        const int row0 = u.pm * 256 + wr * 64 + fr, col0 = u.pn * 256 + wc * 32 + 8 * fq;
#pragma unroll
        for (int ai = 0; ai < 2; ++ai)
#pragma unroll
            for (int m = 0; m < 4; ++m) { bf16_t* rowp = O + (size_t)(row0 + ai * 128 + m * 16) * ldc + col0;
#pragma unroll
                for (int bj = 0; bj < 2; ++bj) { const f32x4 v0 = acc[ai][bj][m][0], v1 = acc[ai][bj][m][1];
                    u32x4 w; w.x = cvt_pk_bf16(v0[0], v0[1]); w.y = cvt_pk_bf16(v0[2], v0[3]); w.z = cvt_pk_bf16(v1[0], v1[1]); w.w = cvt_pk_bf16(v1[2], v1[3]);
                    *(u32x4*)(rowp + bj * 128) = w; } }
    }
};
struct EpiLora {
    static constexpr bool PERM = true;
    h16* O; const float* lb;
    __device__ __forceinline__ void operator()(const f32x4 (&acc)[2][2][4][2], const Unit& u, int wr, int wc, int fr, int fq) const {
        const int type = u.pn >> 2;
        if (type == 4 && u.pm >= NTOK / 256) return;
        const int row0 = u.pm * 256 + wr * 64 + fr, cc0 = (u.pn & 3) * 256 + wc * 32 + 8 * fq;
        const float* bias = lb + (type < 4 ? type : 3) * 1024;
        const float bsel = type < 4 ? 1.0f : 0.0f;
        h16* base = O + (size_t)type * LORA_STRIDE;
#pragma unroll
        for (int bj = 0; bj < 2; ++bj) {
            const f32x4 b0 = *(const f32x4*)(bias + cc0 + bj * 128) * bsel, b1 = *(const f32x4*)(bias + cc0 + bj * 128 + 4) * bsel;
#pragma unroll
            for (int ai = 0; ai < 2; ++ai)
#pragma unroll
                for (int m = 0; m < 4; ++m) {
                    const f32x4 v0 = acc[ai][bj][m][0] + b0, v1 = acc[ai][bj][m][1] + b1;
                    u32x4 w;
#pragma unroll
                    for (int i = 0; i < 4; ++i) {
                        const float x0 = i < 2 ? v0[2 * i] : v1[2 * i - 4], x1 = i < 2 ? v0[2 * i + 1] : v1[2 * i - 3];
                        const float s0 = sigmoidf_(x0), s1 = sigmoidf_(x1);
                        const float e0 = __expf(-0.60653066f * s0), e1 = __expf(-0.60653066f * s1);
                        const float r0 = type < 2 ? e0 : (type < 4 ? s0 : x0), r1 = type < 2 ? e1 : (type < 4 ? s1 : x1);
                        w[i] = __builtin_bit_cast(unsigned, __builtin_amdgcn_cvt_pkrtz(r0, r1));
                    }
                    *(u32x4*)(base + (size_t)(row0 + ai * 128 + m * 16) * 1024 + cc0 + bj * 128) = w;
                    asm volatile("" ::: "memory"); __builtin_amdgcn_sched_barrier(0);
                }
        }
    }
};
struct EpiRes {
    static constexpr bool PERM = false;
    const float* resid; const float* pe; const float* gmod; float* out; int use_pos;
    __device__ __forceinline__ void operator()(const f32x4 (&acc)[2][2][4][2], const Unit& u, int wr, int wc, int fr, int fq) const {
        const int row0 = u.pm * 256 + wr * 64 + fr, col0 = u.pn * 256 + wc * 32 + 4 * fq;
#pragma unroll
        for (int ai = 0; ai < 2; ++ai)
#pragma unroll
            for (int m = 0; m < 4; ++m) { const int r = row0 + ai * 128 + m * 16; const int b = r >> 12, t = r & 4095;
#pragma unroll
                for (int bj = 0; bj < 2; ++bj)
#pragma unroll
                    for (int n = 0; n < 2; ++n) { const int c = col0 + bj * 128 + n * 16;
                        f32x4 rs = *(const f32x4*)(resid + (size_t)r * D + c);
                        if (use_pos) { const float* pp = c < 1024 ? pe + (t >> 6) * 1024 + c : pe + (t & 63) * 1024 + (c - 1024); rs += *(const f32x4*)pp; }
                        const f32x4 gv = *(const f32x4*)(gmod + (size_t)b * 6 * D + c);
                        *(f32x4*)(out + (size_t)r * D + c) = rs * ALPHA + gv * acc[ai][bj][m][n]; } }
    }
};
struct EpiSwiglu {
    static constexpr bool PERM = true;
    bf16_t* O;
    __device__ __forceinline__ void operator()(const f32x4 (&acc)[2][2][4][2], const Unit& u, int wr, int wc, int fr, int fq) const {
        const int row0 = u.pm * 256 + wr * 64 + fr, col0 = u.pn * 128 + wc * 32 + 8 * fq;
#pragma unroll
        for (int ai = 0; ai < 2; ++ai)
#pragma unroll
            for (int m = 0; m < 4; ++m) {
                float o[8];
#pragma unroll
                for (int i = 0; i < 8; ++i) { const float a = acc[ai][0][m][i >> 2][i & 3], b = acc[ai][1][m][i >> 2][i & 3]; o[i] = a * sigmoidf_(a) * b; }
                u32x4 w; w.x = cvt_pk_bf16(o[0], o[1]); w.y = cvt_pk_bf16(o[2], o[3]); w.z = cvt_pk_bf16(o[4], o[5]); w.w = cvt_pk_bf16(o[6], o[7]);
                *(u32x4*)(O + (size_t)(row0 + ai * 128 + m * 16) * DFF + col0) = w;
            }
    }
};

constexpr int TRN = 256;
template <class Map>
__device__ __forceinline__ void tr_tile(LAS float* tile, const float* src, int N, int k0, int n0, bf16_t* dst, int ldd, const Map& map) {
    const int tid = threadIdx.x;
    __syncthreads();
    {
        const int n4 = (tid & 63) * 4, kb = tid >> 6;
        f32x4 v[8];
#pragma unroll
        for (int pp = 0; pp < 8; ++pp) { v[pp] = (f32x4){0.f, 0.f, 0.f, 0.f}; if (n0 + n4 < N) v[pp] = *(const f32x4*)(src + (size_t)(k0 + kb + pp * 8) * N + n0 + n4); }
#pragma unroll
        for (int pp = 0; pp < 8; ++pp)
#pragma unroll
            for (int i = 0; i < 4; ++i) tile[(n4 + i) * 65 + kb + pp * 8] = v[pp][i];
    }
    __syncthreads();
    const int n = tid >> 1, ks = (tid & 1) * 32;
    if (n0 + n < N) {
        bf16_t* drow = dst + (size_t)map(n0 + n) * ldd + k0 + ks;
#pragma unroll
        for (int q = 0; q < 4; ++q) {
            float v[8];
#pragma unroll
            for (int i = 0; i < 8; ++i) v[i] = tile[n * 65 + ks + q * 8 + i];
            u32x4 w; w.x = cvt_pk_bf16(v[0], v[1]); w.y = cvt_pk_bf16(v[2], v[3]); w.z = cvt_pk_bf16(v[4], v[5]); w.w = cvt_pk_bf16(v[6], v[7]);
            *(u32x4*)(drow + q * 8) = w;
        }
    }
}
struct MapWin { __device__ int operator()(int n) const { return n < RW_COLS ? n : n + (RWP - RW_COLS); } };
struct MapId { __device__ int operator()(int n) const { return n; } };
struct MapFF { int add; __device__ int operator()(int n) const { return (n >> 7) * 256 + (n & 127) + add; } };

__device__ __forceinline__ void seq_nb(int row, bool& has_prev, bool& has_next) {
    if (row < NTOK) { const int t = row & (SEQ - 1); has_prev = t > 0; has_next = t < SEQ - 1; }
    else { const int t = (row - NTOK) & (CTX - 1); has_prev = t > 0; has_next = t < CTX - 1; }
}

__device__ __forceinline__ void phase_prep(const Params& p, LAS unsigned char* lds) {
    const int tid = threadIdx.x, G = gridDim.x, bid = blockIdx.x;
    unsigned char* ws = p.ws;
    {
        LAS float* tile = (LAS float*)lds;
        bf16_t* WinT = (bf16_t*)(ws + OFF_R1); bf16_t* WoutT = (bf16_t*)(ws + OFF_WOUT);
        const int nt_in = 32 * 26, nt_out = 32 * 8;
        for (int u = bid; u < nt_in + nt_out; u += G) {
            if (u < nt_in) tr_tile(tile, p.in[I_WIN], IN_COLS, (u & 31) * 64, (u >> 5) * TRN, WinT, D, MapWin());
            else { const int v = u - nt_in; tr_tile(tile, p.in[I_WOUT], D, (v & 31) * 64, (v >> 5) * TRN, WoutT, D, MapId()); }
        }
        __syncthreads();
        u32x4* z = (u32x4*)(WinT + (size_t)RW_COLS * D);
        for (int i = bid * NTHREADS + tid; i < (RWP - RW_COLS) * D / 8; i += G * NTHREADS) z[i] = (u32x4){0u, 0u, 0u, 0u};
    }
    {
        bf16_t* Bt2 = (bf16_t*)(ws + OFF_BT2);
        for (int i = bid * NTHREADS + tid; i < NL * KL / 2; i += G * NTHREADS) {
            const int n = (i * 2) / KL, k = (i * 2) % KL, type = n >> 10, col = n & 1023;
            float v[2];
#pragma unroll
            for (int j = 0; j < 2; ++j) { const int kk = k + j; float x = 0.f;
                if (type < 2) { if (kk < 64) x = p.in[type == 0 ? I_WUPF : I_WUPB][kk * 1024 + col]; }
                else if (type < 4) { if (kk >= 64 && kk < 128) x = p.in[type == 2 ? I_AUPF : I_AUPB][(kk - 64) * 1024 + col]; }
                else { if (kk >= 128 && kk < 288) x = p.in[I_GUP][(kk - 128) * 1024 + col]; }
                v[j] = x; }
            ((unsigned*)Bt2)[i] = cvt_pk_bf16(v[0], v[1]);
        }
    }
    {
        LAS float* sv = (LAS float*)lds;
        float* modp = (float*)(ws + OFF_MODP);
        for (int u = bid; u < 256; u += G) {
            const int kc = u >> 3, nc = u & 7;
            __syncthreads();
            if (tid < 320) { const int b = tid >> 6, k = kc * 64 + (tid & 63); const float cv = b < 4 ? p.in[I_C][b * D + k] : p.in[I_CCTX][k]; sv[tid] = cv * sigmoidf_(cv); }
            __syncthreads();
            float acc[5][3];
#pragma unroll
            for (int b = 0; b < 5; ++b)
#pragma unroll
                for (int j = 0; j < 3; ++j) acc[b][j] = 0.f;
            const float* wp = p.in[I_WADA] + (size_t)(kc * 64) * (6 * D) + nc * 1536 + tid;
#pragma unroll 8
            for (int k = 0; k < 64; ++k) {
                const float w0 = wp[(size_t)k * 6 * D], w1 = wp[(size_t)k * 6 * D + 512], w2 = wp[(size_t)k * 6 * D + 1024];
#pragma unroll
                for (int b = 0; b < 5; ++b) { const float s = sv[b * 64 + k]; acc[b][0] += s * w0; acc[b][1] += s * w1; acc[b][2] += s * w2; }
            }
#pragma unroll
            for (int b = 0; b < 5; ++b)
#pragma unroll
                for (int j = 0; j < 3; ++j) modp[((size_t)kc * 5 + b) * (6 * D) + nc * 1536 + tid + j * 512] = acc[b][j];
        }
    }
    {
        LAS float* zs = (LAS float*)lds;
        LAS float* h1 = zs + 16 * 33;
        float* h2 = (float*)(ws + OFF_H2);
        for (int u = bid; u < 256; u += G) {
            __syncthreads();
            for (int i = tid; i < 16 * 33; i += NTHREADS) { const int pl = i / 33, j = i % 33; const int pos = u * 16 + pl; float v;
                if (j == 0) v = (float)pos / 4095.0f;
                else { const int bi = (j - 1) & 15; const float band = 1e-4f + (float)bi * ((15.0f - 1e-4f) / 15.0f);
                    const float ang = 6.283185307179586f * band * (float)pos / 4096.0f; v = j <= 16 ? cosf(ang) : -sinf(ang); }
                zs[i] = v; }
            __syncthreads();
            const int pl = tid >> 5, l32 = tid & 31;
#pragma unroll
            for (int oo = 0; oo < 2; ++oo) { const int o = l32 + oo * 32; float s = p.in[I_FB1][o];
#pragma unroll 3
                for (int i = 0; i < 33; ++i) s += zs[pl * 33 + i] * p.in[I_FW1][i * 64 + o];
                h1[pl * 64 + o] = sinf(p.in[I_SINF][o] * s); }
            __syncthreads();
#pragma unroll
            for (int oo = 0; oo < 2; ++oo) { const int o = l32 + oo * 32; float s = p.in[I_FB2][o];
#pragma unroll 4
                for (int i = 0; i < 64; ++i) s += h1[pl * 64 + i] * p.in[I_FW2][i * 64 + o];
                h2[(size_t)(u * 16 + pl) * 64 + o] = sinf(p.in[I_SINF][o] * s); }
        }
    }
    { float* lb = (float*)(ws + OFF_LB);
      for (int i = bid * NTHREADS + tid; i < 4096; i += G * NTHREADS) { const int ty = i >> 10, c = i & 1023; lb[i] = p.in[ty == 0 ? I_W0F : ty == 1 ? I_W0B : ty == 2 ? I_A0F : I_A0B][c]; } }
    {
        float* pe = (float*)(ws + OFF_PE);
        for (int i = bid * NTHREADS + tid; i < 64 * 1024; i += G * NTHREADS) {
            const int r = i >> 10, d = i & 1023, q = d & 511;
            const float omega = 1.0f / powf(10000.0f, (float)q / 512.0f);
            const float a = (float)r * omega;
            pe[i] = d < 512 ? sinf(a) : cosf(a);
        }
    }
}

__device__ __forceinline__ void phase_modfin(const Params& p) {
    float* mod = (float*)(p.ws + OFF_MOD); const float* modp = (const float*)(p.ws + OFF_MODP);
    for (int i = blockIdx.x * NTHREADS + threadIdx.x; i < 5 * 6 * D; i += gridDim.x * NTHREADS) {
        float s = p.in[I_BADA][i % (6 * D)];
        for (int kc = 0; kc < 32; ++kc) s += modp[(size_t)kc * 5 * 6 * D + i];
        mod[i] = s;
    }
    {
        const float* h2 = (const float*)(p.ws + OFF_H2); const float* w3 = p.in[I_FW3]; float* HFT = p.out;
        const int lane = threadIdx.x & 63, wv = __builtin_amdgcn_readfirstlane(threadIdx.x >> 6);
        for (int u = blockIdx.x; u < 512; u += gridDim.x) {
            const int pt = u >> 3, cb = u & 7;
            f32x4 hr[16];
#pragma unroll
            for (int q = 0; q < 16; ++q) hr[q] = *(const f32x4*)(h2 + (size_t)(pt * 64 + lane) * 64 + q * 4);
            const int c0 = cb * 256 + wv * 32;
            for (int cc = 0; cc < 32; cc += 4) {
                float a0 = 0.f, a1 = 0.f, a2 = 0.f, a3 = 0.f;
#pragma unroll
                for (int q = 0; q < 16; ++q) {
#pragma unroll
                    for (int jj = 0; jj < 4; ++jj) { const f32x4 wq = *(const f32x4*)(w3 + (size_t)(q * 4 + jj) * 2048 + c0 + cc); const float hv = hr[q][jj];
                        a0 += hv * wq[0]; a1 += hv * wq[1]; a2 += hv * wq[2]; a3 += hv * wq[3]; }
                    if ((q & 3) == 3) __builtin_amdgcn_sched_barrier(0);
                }
                float* o = HFT + (size_t)(c0 + cc) * 4096 + pt * 64 + lane;
                o[0] = a0; o[4096] = a1; o[2 * 4096] = a2; o[3 * 4096] = a3;
            }
        }
    }
}

__device__ __forceinline__ void phase_a1(const Params& p) {
    const float* mod = (const float*)(p.ws + OFF_MOD); const float* pe = (const float*)(p.ws + OFF_PE);
    bf16_t* A1 = (bf16_t*)(p.ws + OFF_R4);
    for (int i = blockIdx.x * NTHREADS + threadIdx.x; i < (MROWS / 4) * (D / 4); i += gridDim.x * NTHREADS) {
        const int r0 = (i >> 9) * 4, d = (i & 511) * 4;
        const bool lat = r0 < NTOK; const int mb = lat ? (r0 >> 12) : 4;
        const float* src = lat ? p.in[I_X] + (size_t)r0 * D + d : p.in[I_CTX] + (size_t)(r0 - NTOK) * D + d;
        f32x4 v[4];
#pragma unroll
        for (int j = 0; j < 4; ++j) v[j] = *(const f32x4*)(src + (size_t)j * D);
        const f32x4 sh = *(const f32x4*)(mod + (size_t)mb * 6 * D + d), sc = *(const f32x4*)(mod + (size_t)mb * 6 * D + D + d) + 1.0f;
        if (lat) {
            const int t = r0 & 4095;
#pragma unroll
            for (int j = 0; j < 4; ++j) { const float* pp = d < 1024 ? pe + (t >> 6) * 1024 + d : pe + ((t + j) & 63) * 1024 + (d - 1024); v[j] += *(const f32x4*)pp; }
        }
#pragma unroll
        for (int j = 0; j < 4; ++j) { const f32x4 o = v[j] * sc + sh; u32x2 w; w.x = cvt_pk_bf16(o[0], o[1]); w.y = cvt_pk_bf16(o[2], o[3]); *(u32x2*)(A1 + (size_t)(r0 + j) * D + d) = w; }
    }
}

__device__ __forceinline__ void ld8(const bf16_t* ptr, bool valid, float (&o)[8]) {
    u32x4 w = (u32x4){0u, 0u, 0u, 0u};
    if (valid) w = *(const u32x4*)ptr;
#pragma unroll
    for (int i = 0; i < 4; ++i) { o[2 * i] = __uint_as_float(w[i] << 16); o[2 * i + 1] = __uint_as_float(w[i] & 0xffff0000u); }
}
__device__ __forceinline__ void conv8(const bf16_t* proj, int row, bool hp, bool hn, int col, const float* cw, int ldw, int wcol, float (&o)[8]) {
    float a[8], b[8], c[8];
    const bf16_t* pr = proj + (size_t)row * NP + col;
    ld8(pr - NP, hp, a); ld8(pr, true, b); ld8(pr + NP, hn, c);
#pragma unroll
    for (int i = 0; i < 8; ++i) o[i] = cw[wcol + i] * a[i] + cw[ldw + wcol + i] * b[i] + cw[2 * ldw + wcol + i] * c[i];
}

__device__ __forceinline__ void hy_raw3(const bf16_t* pr, bool hp, bool hn, u32x4 (&r)[3]) {
    const u32x4 z = (u32x4){0u, 0u, 0u, 0u};
    r[0] = hp ? *(const u32x4*)(pr - NP) : z; r[1] = *(const u32x4*)pr; r[2] = hn ? *(const u32x4*)(pr + NP) : z;
}
__device__ __forceinline__ void hy_raw2(const bf16_t* proj, int u, int tl, int cs, u32x4 (&ra)[3], u32x4 (&rb)[3]) {
    const int ct = u & 15, tt = (u >> 4) & 63, b = u >> 10, t = tt * 64 + tl, c = ct * 64 + cs;
    const bf16_t* pr = proj + (size_t)(b * SEQ + t) * NP + RWP + c;
    hy_raw3(pr + 1024, t > 0, t < SEQ - 1, ra); hy_raw3(pr + 2048, t > 0, t < SEQ - 1, rb);
}
struct HyW { float w[3][8]; float b[8]; };
__device__ __forceinline__ void hy_wload(HyW& W, const float* cw, const float* bias, int ldw, int wcol) {
#pragma unroll
    for (int i = 0; i < 8; ++i) { W.w[0][i] = cw[wcol + i]; W.w[1][i] = cw[ldw + wcol + i]; W.w[2][i] = cw[2 * ldw + wcol + i]; W.b[i] = bias[wcol + i]; }
}
__device__ __forceinline__ void hy_convw(const u32x4 (&r)[3], const HyW& W, float (&o)[8]) {
#pragma unroll
    for (int i = 0; i < 8; ++i) {
        const float a = (i & 1) ? __uint_as_float(r[0][i >> 1] & 0xffff0000u) : __uint_as_float(r[0][i >> 1] << 16);
        const float b = (i & 1) ? __uint_as_float(r[1][i >> 1] & 0xffff0000u) : __uint_as_float(r[1][i >> 1] << 16);
        const float c = (i & 1) ? __uint_as_float(r[2][i >> 1] & 0xffff0000u) : __uint_as_float(r[2][i >> 1] << 16);
        o[i] = W.w[0][i] * a + W.w[1][i] * b + W.w[2][i] * c + W.b[i];
    }
}
__device__ __forceinline__ void hy_conv(const u32x4 (&r)[3], const float* cw, int ldw, int wcol, float (&o)[8]) {
#pragma unroll
    for (int i = 0; i < 8; ++i) {
        const float a = (i & 1) ? __uint_as_float(r[0][i >> 1] & 0xffff0000u) : __uint_as_float(r[0][i >> 1] << 16);
        const float b = (i & 1) ? __uint_as_float(r[1][i >> 1] & 0xffff0000u) : __uint_as_float(r[1][i >> 1] << 16);
        const float c = (i & 1) ? __uint_as_float(r[2][i >> 1] & 0xffff0000u) : __uint_as_float(r[2][i >> 1] << 16);
        o[i] = cw[wcol + i] * a + cw[ldw + wcol + i] * b + cw[2 * ldw + wcol + i] * c;
    }
}

__device__ __forceinline__ void phase_post_proj(const Params& p, LAS unsigned char* lds) {
    const int tid = threadIdx.x, G = gridDim.x, bid = blockIdx.x;
    const bf16_t* proj = (const bf16_t*)(p.ws + OFF_R5);
    bf16_t* A2 = (bf16_t*)(p.ws + OFF_R1);
    LAS float* cwl = (LAS float*)lds;
    __syncthreads();
    for (int i = tid; i < 3 * 288; i += NTHREADS) cwl[i] = p.in[I_CONVRW][(i / 288) * RW_COLS + 3072 + (i % 288)];
    __syncthreads();
    for (size_t i = (size_t)bid * NTHREADS + tid; i < (size_t)MROWS * 48; i += (size_t)G * NTHREADS) {
        const int row = (int)(i / 48), g = (int)(i % 48);
        u32x4 w = (u32x4){0u, 0u, 0u, 0u};
        if (g < 36) { bool hp, hn; seq_nb(row, hp, hn); float v[8];
            { float a[8], b[8], c[8];
              const bf16_t* pr = proj + (size_t)row * NP + 3072 + g * 8;
              ld8(pr - NP, hp, a); ld8(pr, true, b); ld8(pr + NP, hn, c);
              const f32x4 w0a = *(const LAS f32x4*)(cwl + g * 8), w0b = *(const LAS f32x4*)(cwl + g * 8 + 4), w1a = *(const LAS f32x4*)(cwl + 288 + g * 8), w1b = *(const LAS f32x4*)(cwl + 288 + g * 8 + 4),
                          w2a = *(const LAS f32x4*)(cwl + 576 + g * 8), w2b = *(const LAS f32x4*)(cwl + 576 + g * 8 + 4);
#pragma unroll
              for (int j = 0; j < 4; ++j) { v[j] = w0a[j] * a[j] + w1a[j] * b[j] + w2a[j] * c[j]; v[4 + j] = w0b[j] * a[4 + j] + w1b[j] * b[4 + j] + w2b[j] * c[4 + j]; } }
#pragma unroll
            for (int j = 0; j < 8; ++j) { const float th = 1.0f - 2.0f * __builtin_amdgcn_rcpf(1.0f + __expf(2.0f * v[j])), sg = sigmoidf_(v[j]); v[j] = g < 8 ? th : (g >= 16 ? sg : v[j]); }
            w.x = cvt_pk_bf16(v[0], v[1]); w.y = cvt_pk_bf16(v[2], v[3]); w.z = cvt_pk_bf16(v[4], v[5]); w.w = cvt_pk_bf16(v[6], v[7]); }
        *(u32x4*)(A2 + (size_t)row * KL + g * 8) = w;
    }
    LAS float* tile = (LAS float*)lds;
    bf16_t* zT = (bf16_t*)(p.ws + OFF_R4);
    {
        const int tl = tid >> 3, cs = (tid & 7) * 8;
        u32x4 ra[3], rb[3], na[3], nb[3];
        HyW W1, W2; int ctw = -1;
        if (bid < 4096) hy_raw2(proj, bid, tl, cs, ra, rb);
        for (int u = bid; u < 4096; u += G) {
            const int ct = u & 15, tt = (u >> 4) & 63, b = u >> 10, c = ct * 64 + cs;
            hy_raw2(proj, u + G < 4096 ? u + G : u, tl, cs, na, nb);
            float x1[8], vv[8];
            if (ct != ctw) { hy_wload(W1, p.in[I_CONVHY], p.in[I_CONVHYB], 3072, 1024 + c); hy_wload(W2, p.in[I_CONVHY], p.in[I_CONVHYB], 3072, 2048 + c); ctw = ct; }
            hy_convw(ra, W1, x1); hy_convw(rb, W2, vv);
            __syncthreads();
#pragma unroll
            for (int i = 0; i < 8; ++i) tile[(cs + i) * 65 + tl] = vv[i] * x1[i];
            __syncthreads();
            const int cl = tid >> 3, ts = (tid & 7) * 8;
            f32x4 o0, o1;
#pragma unroll
            for (int i = 0; i < 4; ++i) { o0[i] = tile[cl * 65 + ts + i]; o1[i] = tile[cl * 65 + ts + 4 + i]; }
            bf16_t* dst = zT + ((size_t)(b * 1024 + ct * 64 + cl)) * SEQ + tt * 64 + ts;
            u32x4 zw; zw.x = cvt_pk_bf16(o0[0], o0[1]); zw.y = cvt_pk_bf16(o0[2], o0[3]); zw.z = cvt_pk_bf16(o1[0], o1[1]); zw.w = cvt_pk_bf16(o1[2], o1[3]);
            *(u32x4*)dst = zw;
#pragma unroll
            for (int i = 0; i < 3; ++i) { ra[i] = na[i]; rb[i] = nb[i]; }
        }
    }
}

__device__ __forceinline__ int fpad(int n) { return n + ((n >> 5) << 1); }
__device__ __forceinline__ f32x2 cmul(f32x2 a, f32x2 b) { return (f32x2){b.x, b.x} * a + (f32x2){b.y, b.y} * (f32x2){-a.y, a.x}; }
__device__ __forceinline__ f32x2 cmulc(f32x2 a, f32x2 b) { return (f32x2){b.x, b.x} * a + (f32x2){b.y, b.y} * (f32x2){a.y, -a.x}; }

template <int LO> __device__ __forceinline__ int fft_base(int g) { return ((g >> LO) << (LO + 4)) | (g & ((1 << LO) - 1)); }
template <int LO> __device__ __forceinline__ void fft_load(const LAS f32x2* x, int base, f32x2 (&v)[16]) {
#pragma unroll
    for (int r = 0; r < 16; ++r) v[r] = x[fpad(base | (r << LO))];
}
template <int LO> __device__ __forceinline__ void fft_store(LAS f32x2* x, int base, const f32x2 (&v)[16]) {
#pragma unroll
    for (int r = 0; r < 16; ++r) x[fpad(base | (r << LO))] = v[r];
}
template <int LO> __device__ __forceinline__ void fft_twset(const LAS f32x2* tw, int g, f32x2 (&T)[4]) {
    const int gl = g & ((1 << LO) - 1);
#pragma unroll
    for (int sb = 0; sb < 4; ++sb) T[sb] = tw[gl << (12 - LO - sb)];
}
template <int SB, int M> __device__ __forceinline__ f32x2 cconst() { const float ang = -6.283185307179586f * (float)M / (float)(2 << SB); return (f32x2){__builtin_cosf(ang), __builtin_sinf(ang)}; }
template <int SB, int R> __device__ __forceinline__ void bfly_fwd(const f32x2 (&T)[4], f32x2 (&v)[16]) {
    if constexpr (!(R & (1 << SB))) {
        constexpr int R2 = R | (1 << SB), M = R & ((1 << SB) - 1);
        const f32x2 a = v[R], b = v[R2];
        v[R] = a + b; f32x2 d = a - b;
        if constexpr (M != 0) d = cmul(d, cconst<SB, M>());
        v[R2] = cmul(d, T[SB]);
    }
}
template <int SB, int R> __device__ __forceinline__ void bfly_inv(const f32x2 (&T)[4], f32x2 (&v)[16]) {
    if constexpr (!(R & (1 << SB))) {
        constexpr int R2 = R | (1 << SB), M = R & ((1 << SB) - 1);
        f32x2 b = cmulc(v[R2], T[SB]);
        if constexpr (M != 0) b = cmulc(b, cconst<SB, M>());
        const f32x2 a = v[R];
        v[R] = a + b; v[R2] = a - b;
    }
}
template <int SB> __device__ __forceinline__ void stage_fwd(const f32x2 (&T)[4], f32x2 (&v)[16]) {
    bfly_fwd<SB, 0>(T, v); bfly_fwd<SB, 1>(T, v); bfly_fwd<SB, 2>(T, v); bfly_fwd<SB, 3>(T, v); bfly_fwd<SB, 4>(T, v); bfly_fwd<SB, 5>(T, v); bfly_fwd<SB, 6>(T, v); bfly_fwd<SB, 7>(T, v);
    bfly_fwd<SB, 8>(T, v); bfly_fwd<SB, 9>(T, v); bfly_fwd<SB, 10>(T, v); bfly_fwd<SB, 11>(T, v); bfly_fwd<SB, 12>(T, v); bfly_fwd<SB, 13>(T, v); bfly_fwd<SB, 14>(T, v); bfly_fwd<SB, 15>(T, v);
}
template <int SB> __device__ __forceinline__ void stage_inv(const f32x2 (&T)[4], f32x2 (&v)[16]) {
    bfly_inv<SB, 0>(T, v); bfly_inv<SB, 1>(T, v); bfly_inv<SB, 2>(T, v); bfly_inv<SB, 3>(T, v); bfly_inv<SB, 4>(T, v); bfly_inv<SB, 5>(T, v); bfly_inv<SB, 6>(T, v); bfly_inv<SB, 7>(T, v);
    bfly_inv<SB, 8>(T, v); bfly_inv<SB, 9>(T, v); bfly_inv<SB, 10>(T, v); bfly_inv<SB, 11>(T, v); bfly_inv<SB, 12>(T, v); bfly_inv<SB, 13>(T, v); bfly_inv<SB, 14>(T, v); bfly_inv<SB, 15>(T, v);
}
template <int LO> __device__ __forceinline__ void fft_fwd(const f32x2 (&T)[4], f32x2 (&v)[16]) { stage_fwd<3>(T, v); stage_fwd<2>(T, v); stage_fwd<1>(T, v); stage_fwd<0>(T, v); }
template <int LO> __device__ __forceinline__ void fft_inv(const f32x2 (&T)[4], f32x2 (&v)[16]) { stage_inv<0>(T, v); stage_inv<1>(T, v); stage_inv<2>(T, v); stage_inv<3>(T, v); }
__device__ __forceinline__ void fft_fwd0(const LAS f32x2* tw, f32x2 (&v)[16]) {
#pragma unroll
    for (int sb = 3; sb >= 0; --sb) {
#pragma unroll
        for (int r = 0; r < 16; ++r) if (!(r & (1 << sb))) {
            const int r2 = r | (1 << sb);
            const f32x2 a = v[r], b = v[r2];
            v[r] = a + b; v[r2] = cmul(a - b, tw[(r & ((1 << sb) - 1)) << (12 - sb)]);
        }
    }
}
__device__ __forceinline__ void fft_inv0(const LAS f32x2* tw, f32x2 (&v)[16]) {
#pragma unroll
    for (int sb = 0; sb < 4; ++sb) {
#pragma unroll
        for (int r = 0; r < 16; ++r) if (!(r & (1 << sb))) {
            const int r2 = r | (1 << sb);
            const f32x2 a = v[r], b = cmulc(v[r2], tw[(r & ((1 << sb) - 1)) << (12 - sb)]);
            v[r] = a + b; v[r2] = a - b;
        }
    }
}

__device__ __forceinline__ void phase_hyena_fft(const Params& p, LAS unsigned char* lds) {
    const int tid = threadIdx.x, G = gridDim.x, bid = blockIdx.x;
    LAS f32x2* x = (LAS f32x2*)lds;
    LAS f32x2* tw = (LAS f32x2*)(lds + 8704 * 8);
    __syncthreads();
    for (int k = tid; k < 4096; k += NTHREADS) { float s, c; sincosf(-6.283185307179586f * (float)k / 8192.0f, &s, &c); tw[k] = (f32x2){c, s}; }
    const float* h2 = (const float*)(p.ws + OFF_H2);
    bf16_t* zT = (bf16_t*)(p.ws + OFF_R4);
    const float* HFT = p.out;
    f32x2 v[16], kf[16], T8[4], T4[4];
    __syncthreads();
    fft_twset<8>(tw, tid, T8); fft_twset<4>(tw, tid, T4);
#ifndef FFT_REPS
#define FFT_REPS 1
#endif
    for (int c = bid; c < HY; c += G) for (int frep = 0; frep < FFT_REPS; ++frep) {
        __syncthreads();
        {
            const float delta = fabsf(-3.0701134573253945f + (float)c * ((-15.350567286626973f + 3.0701134573253945f) / 1023.0f));
            const float bias = p.in[I_HYB][c];
#pragma unroll 2
            for (int i = 0; i < 8; ++i) {
                const int n = tid + i * NTHREADS;
                const int nb = n == 0 ? 0 : 4096 - n;
                const float sf = HFT[(size_t)c * 4096 + n], sb = HFT[(size_t)(1024 + c) * 4096 + nb];
                float klo = sf * __expf(-((float)n * (1.0f / 4095.0f)) * delta), khi = sb * __expf(-((float)nb * (1.0f / 4095.0f)) * delta);
                if (n == 0) { klo += bias; khi = 0.f; }
                const f32x2 d = (f32x2){klo - khi, 0.f};
                x[fpad(n)] = (f32x2){klo + khi, 0.f}; x[fpad(n + 4096)] = cmul(d, tw[n]);
            }
        }
        __syncthreads();
        { const int b8 = fft_base<8>(tid); fft_load<8>(x, b8, v); fft_fwd<8>(T8, v); fft_store<8>(x, b8, v); }
        __syncthreads();
        { const int b4 = fft_base<4>(tid); fft_load<4>(x, b4, v); fft_fwd<4>(T4, v); fft_store<4>(x, b4, v); }
        __syncthreads();
        { const int b0 = fft_base<0>(tid); fft_load<0>(x, b0, kf); fft_fwd0(tw, kf); }
#pragma unroll
        for (int r = 0; r < 16; ++r) kf[r] *= (1.0f / 8192.0f);
        for (int pair = 0; pair < 2; ++pair) {
            bf16_t* z0 = zT + ((size_t)((2 * pair) * 1024 + c)) * SEQ; bf16_t* z1 = zT + ((size_t)((2 * pair + 1) * 1024 + c)) * SEQ;
            __syncthreads();
#pragma unroll 2
            for (int i = 0; i < 8; ++i) { const int n = tid + i * NTHREADS; const f32x2 a = (f32x2){bf2f(z0[n]), bf2f(z1[n])}; x[fpad(n)] = a; x[fpad(n + 4096)] = cmul(a, tw[n]); }
            __syncthreads();
            { const int b8 = fft_base<8>(tid); fft_load<8>(x, b8, v); fft_fwd<8>(T8, v); fft_store<8>(x, b8, v); }
            __syncthreads();
            { const int b4 = fft_base<4>(tid); fft_load<4>(x, b4, v); fft_fwd<4>(T4, v); fft_store<4>(x, b4, v); }
            __syncthreads();
            { const int b0 = fft_base<0>(tid); fft_load<0>(x, b0, v); fft_fwd0(tw, v);
#pragma unroll
              for (int r = 0; r < 16; ++r) v[r] = cmul(v[r], kf[r]);
              fft_inv0(tw, v); fft_store<0>(x, b0, v); }
            __syncthreads();
            { const int b4 = fft_base<4>(tid); fft_load<4>(x, b4, v); fft_inv<4>(T4, v); fft_store<4>(x, b4, v); }
            __syncthreads();
            { const int b8 = fft_base<8>(tid); fft_load<8>(x, b8, v); fft_inv<8>(T8, v); fft_store<8>(x, b8, v); }
            __syncthreads();
#pragma unroll 2
            for (int i = 0; i < 8; ++i) { const int n = tid + i * NTHREADS; const f32x2 y = x[fpad(n)] + cmulc(x[fpad(n + 4096)], tw[n]); if (frep == FFT_REPS - 1) { const unsigned pk = cvt_pk_bf16(y.x, y.y); z0[n] = (bf16_t)(pk & 0xffffu); z1[n] = (bf16_t)(pk >> 16); } }
        }
    }
}

struct ScanRaw { u32x4 pr[3], pk[3], pv[3]; u32x4 w, a; };
constexpr int SC_T = 32;
constexpr int SC_BUF = (5 * SC_T * 64 + SC_T * 32) * 4;
constexpr int SC_NCH = (CTX + SEQ) / SC_T;

__device__ __forceinline__ void scan_rows(int ci, int st, int dir, int b, int& row, bool& hp, bool& hn, bool& latent, int& t) {
    int sg = ci * SC_T + st;
    if (sg < CTX) { t = dir ? CTX - 1 - sg : sg; row = NTOK + b * CTX + t; hp = t > 0; hn = t < CTX - 1; latent = false; }
    else { sg -= CTX; t = dir ? SEQ - 1 - sg : sg; row = b * SEQ + t; hp = t > 0; hn = t < SEQ - 1; latent = true; }
}
__device__ __forceinline__ void scan_issue(const bf16_t* proj, const h16* wd, const h16* ad, int ci, int st, int dir, int b, int ch, ScanRaw& q) {
    int row, t; bool hp, hn, lat; scan_rows(ci, st, dir, b, row, hp, hn, lat, t);
    const bf16_t* pr = proj + (size_t)row * NP + ch;
    const u32x4 z = (u32x4){0u, 0u, 0u, 0u};
    q.pr[0] = hp ? *(const u32x4*)(pr - NP) : z; q.pr[1] = *(const u32x4*)pr; q.pr[2] = hn ? *(const u32x4*)(pr + NP) : z;
    q.pk[0] = hp ? *(const u32x4*)(pr - NP + 1024) : z; q.pk[1] = *(const u32x4*)(pr + 1024); q.pk[2] = hn ? *(const u32x4*)(pr + NP + 1024) : z;
    q.pv[0] = hp ? *(const u32x4*)(pr - NP + 2048) : z; q.pv[1] = *(const u32x4*)(pr + 2048); q.pv[2] = hn ? *(const u32x4*)(pr + NP + 2048) : z;
    q.w = *(const u32x4*)(wd + (size_t)row * 1024 + ch); q.a = *(const u32x4*)(ad + (size_t)row * 1024 + ch);
}
__device__ __forceinline__ float bfe(const u32x4& w, int i) { return (i & 1) ? __uint_as_float(w[i >> 1] & 0xffff0000u) : __uint_as_float(w[i >> 1] << 16); }
__device__ __forceinline__ float h16e(const u32x4& w, int i) { const unsigned short s = (unsigned short)((i & 1) ? (w[i >> 1] >> 16) : (w[i >> 1] & 0xffffu)); return (float)__builtin_bit_cast(h16, s); }

struct ScanOps { f32x4 r[2], w[2], k[2], a[2], b[2]; float v; };
__device__ __forceinline__ void scan_ld(ScanOps& o, const LAS float* R, const LAS float* Vp, int sidx) {
#pragma unroll
    for (int q = 0; q < 2; ++q) { o.r[q] = *(const LAS f32x4*)(R + sidx * 64 + q * 32); o.w[q] = *(const LAS f32x4*)(R + SC_T * 64 + sidx * 64 + q * 32); o.k[q] = *(const LAS f32x4*)(R + 2 * SC_T * 64 + sidx * 64 + q * 32);
        o.a[q] = *(const LAS f32x4*)(R + 3 * SC_T * 64 + sidx * 64 + q * 32); o.b[q] = *(const LAS f32x4*)(R + 4 * SC_T * 64 + sidx * 64 + q * 32); }
    o.v = Vp[sidx * 32];
}
__device__ __forceinline__ void scan_step(f32x2 (&s2)[4], const ScanOps& c) {
    f32x2 p0 = s2[0] * (f32x2){c.a[0][0], c.a[0][1]}, p1 = s2[2] * (f32x2){c.a[1][0], c.a[1][1]};
    p0 = s2[1] * (f32x2){c.a[0][2], c.a[0][3]} + p0; p1 = s2[3] * (f32x2){c.a[1][2], c.a[1][3]} + p1;
    p0 += p1;
    const float pa = sum8(p0.x + p0.y);
    const f32x2 vv2 = (f32x2){c.v, c.v}, pa2 = (f32x2){pa, pa};
    const f32x2 t0 = s2[0] * (f32x2){c.w[0][0], c.w[0][1]} + vv2 * (f32x2){c.k[0][0], c.k[0][1]};
    const f32x2 t1 = s2[1] * (f32x2){c.w[0][2], c.w[0][3]} + vv2 * (f32x2){c.k[0][2], c.k[0][3]};
    const f32x2 t2 = s2[2] * (f32x2){c.w[1][0], c.w[1][1]} + vv2 * (f32x2){c.k[1][0], c.k[1][1]};
    const f32x2 t3 = s2[3] * (f32x2){c.w[1][2], c.w[1][3]} + vv2 * (f32x2){c.k[1][2], c.k[1][3]};
    s2[0] = pa2 * (f32x2){c.b[0][0], c.b[0][1]} + t0; s2[1] = pa2 * (f32x2){c.b[0][2], c.b[0][3]} + t1;
    s2[2] = pa2 * (f32x2){c.b[1][0], c.b[1][1]} + t2; s2[3] = pa2 * (f32x2){c.b[1][2], c.b[1][3]} + t3;
}

__device__ __forceinline__ void phase_scan(const Params& p, LAS unsigned char* lds) {
    const int tid = threadIdx.x, G = gridDim.x;
    const bf16_t* proj = (const bf16_t*)(p.ws + OFF_R5);
    const h16* lora = (const h16*)(p.ws + OFF_R6);
    LAS float* cw = (LAS float*)(lds + 2 * SC_BUF);
    for (int u = blockIdx.x; u < 256; u += G) {
        const int half = u & 1, sc = u >> 1, dir = sc >> 6, b = (sc >> 4) & 3, h = sc & 15;
        const h16* wd = lora + (size_t)dir * LORA_STRIDE; const h16* ad = lora + (size_t)(2 + dir) * LORA_STRIDE;
        float* yout = p.out + (size_t)dir * NTOK * 1024;
        __syncthreads();
        for (int i = tid; i < 9 * 64 + 128; i += NTHREADS) {
            float v;
            if (i < 576) { const int which = i / 192, tap = (i / 64) % 3, j = i & 63; v = p.in[I_CONVRW][tap * RW_COLS + which * 1024 + h * 64 + j]; }
            else if (i < 640) v = p.in[I_KK][h * 64 + (i - 576)];
            else v = p.in[I_KA][h * 64 + (i - 640)];
            cw[i] = v;
        }
        __syncthreads();
        const bool producer = tid >= 256;
        const int ptid = tid & 255, st = ptid >> 3, e = ptid & 7;
        ScanRaw raw;
        f32x2 s2[4];
#pragma unroll
        for (int j = 0; j < 4; ++j) s2[j] = (f32x2){0.f, 0.f};
        if (producer) scan_issue(proj, wd, ad, 0, st, dir, b, h * 64 + e * 8, raw);
        for (int ci = -1; ci < SC_NCH; ++ci) {
            if (producer) {
                if (ci + 1 < SC_NCH) {
                    LAS float* buf = (LAS float*)(lds + ((ci + 1) & 1) * SC_BUF);
                    float r[8], k[8], vv[8], kkv[8], w[8], a[8];
                    float nrm = 0.f;
#pragma unroll
                    for (int j = 0; j < 8; ++j) { const int cj = e * 8 + j;
                        r[j] = cw[0 * 64 + cj] * bfe(raw.pr[0], j) + cw[1 * 64 + cj] * bfe(raw.pr[1], j) + cw[2 * 64 + cj] * bfe(raw.pr[2], j);
                        k[j] = cw[3 * 64 + cj] * bfe(raw.pk[0], j) + cw[4 * 64 + cj] * bfe(raw.pk[1], j) + cw[5 * 64 + cj] * bfe(raw.pk[2], j);
                        vv[j] = cw[6 * 64 + cj] * bfe(raw.pv[0], j) + cw[7 * 64 + cj] * bfe(raw.pv[1], j) + cw[8 * 64 + cj] * bfe(raw.pv[2], j);
                        kkv[j] = k[j] * cw[576 + cj]; nrm += kkv[j] * kkv[j];
                        w[j] = h16e(raw.w, j); a[j] = h16e(raw.a, j); }
                    nrm = sum8(nrm);
                    const float inv = __builtin_amdgcn_rsqf(fmaxf(nrm, 1e-24f));
                    f32x4 o;
                    LAS float* R = buf + st * 64 + e * 4;
#pragma unroll
                    for (int q = 0; q < 2; ++q) {
#pragma unroll
                        for (int j = 0; j < 4; ++j) o[j] = r[q * 4 + j];
                        *(LAS f32x4*)(R + q * 32) = o;
#pragma unroll
                        for (int j = 0; j < 4; ++j) o[j] = w[q * 4 + j];
                        *(LAS f32x4*)(R + SC_T * 64 + q * 32) = o;
#pragma unroll
                        for (int j = 0; j < 4; ++j) o[j] = k[q * 4 + j] * (1.0f + (a[q * 4 + j] - 1.0f) * cw[640 + e * 8 + q * 4 + j]);
                        *(LAS f32x4*)(R + 2 * SC_T * 64 + q * 32) = o;
#pragma unroll
                        for (int j = 0; j < 4; ++j) o[j] = -kkv[q * 4 + j] * inv;
                        *(LAS f32x4*)(R + 3 * SC_T * 64 + q * 32) = o;
#pragma unroll
                        for (int j = 0; j < 4; ++j) o[j] = kkv[q * 4 + j] * inv * a[q * 4 + j];
                        *(LAS f32x4*)(R + 4 * SC_T * 64 + q * 32) = o;
                    }
                    if ((e >> 2) == half) {
                        LAS float* V = buf + 5 * SC_T * 64 + st * 32 + (e & 3) * 8;
#pragma unroll
                        for (int q = 0; q < 2; ++q) {
#pragma unroll
                            for (int j = 0; j < 4; ++j) o[j] = vv[q * 4 + j];
                            *(LAS f32x4*)(V + q * 4) = o; }
                    }
                    if (ci + 2 < SC_NCH) scan_issue(proj, wd, ad, ci + 2, st, dir, b, h * 64 + e * 8, raw);
                }
            } else if (ci >= 0) {
                __builtin_amdgcn_s_setprio(2);
                const LAS float* buf = (const LAS float*)(lds + (ci & 1) * SC_BUF);
                const int rowi = ptid >> 3;
                const bool latent = ci >= CTX / SC_T;
                const LAS float* R = buf + e * 4;
                const LAS float* Vp = buf + 5 * SC_T * 64 + rowi;
                ScanOps c0, c1, c2;
                scan_ld(c0, R, Vp, 0); scan_ld(c1, R, Vp, 1);
                if (latent) {
                    const int sg0 = ci * SC_T - CTX; const int t0 = dir ? SEQ - 1 - sg0 : sg0;
                    float* yp = yout + ((size_t)(b * SEQ + t0)) * 1024 + h * 64 + half * 32 + rowi;
                    const long ystride = dir ? -1024 : 1024;
#pragma unroll 3
                    for (int step = 0; step < SC_T; ++step) {
                        scan_ld(c2, R, Vp, step + 2 < SC_T ? step + 2 : SC_T - 1);
                        scan_step(s2, c0);
                        f32x2 q0 = s2[0] * (f32x2){c0.r[0][0], c0.r[0][1]}, q1 = s2[2] * (f32x2){c0.r[1][0], c0.r[1][1]};
                        q0 = s2[1] * (f32x2){c0.r[0][2], c0.r[0][3]} + q0; q1 = s2[3] * (f32x2){c0.r[1][2], c0.r[1][3]} + q1;
                        q0 += q1;
                        const float qy = sum8(q0.x + q0.y);
                        yp[0] = qy; yp += ystride;
                        c0 = c1; c1 = c2;
                    }
                } else {
#pragma unroll 3
                    for (int step = 0; step < SC_T; ++step) {
                        scan_ld(c2, R, Vp, step + 2 < SC_T ? step + 2 : SC_T - 1);
                        scan_step(s2, c0);
                        c0 = c1; c1 = c2;
                    }
                }
                __builtin_amdgcn_s_setprio(0);
            }
            __syncthreads();
        }
    }
}


struct CombIn { u32x2 pw[3][3]; u32x2 afw, abw, gtw; f32x4 y0, y1; };
__device__ __forceinline__ void comb_load(CombIn& q, int task, int l16, const bf16_t* proj, const h16* af, const h16* ab, const h16* gate, const float* yf, const float* yb) {
    const int row = task >> 4, h = task & 15, ch = h * 64 + l16 * 4, t = row & (SEQ - 1);
    const bool hp = t > 0, hn = t < SEQ - 1;
    const bf16_t* pr = proj + (size_t)row * NP + ch;
    const u32x2 z2 = (u32x2){0u, 0u};
#pragma unroll
    for (int w = 0; w < 3; ++w) { q.pw[w][0] = hp ? *(const u32x2*)(pr - NP + w * 1024) : z2; q.pw[w][1] = *(const u32x2*)(pr + w * 1024); q.pw[w][2] = hn ? *(const u32x2*)(pr + NP + w * 1024) : z2; }
    q.afw = *(const u32x2*)(af + (size_t)row * 1024 + ch); q.abw = *(const u32x2*)(ab + (size_t)row * 1024 + ch); q.gtw = *(const u32x2*)(gate + (size_t)row * 1024 + ch);
    q.y0 = *(const f32x4*)(yf + (size_t)row * 1024 + ch); q.y1 = *(const f32x4*)(yb + (size_t)row * 1024 + ch);
}
struct CombPar { f32x4 ka, rk, gg, gb, c[3][3]; };
__device__ __forceinline__ void comb_params(CombPar& P, int h, int l16, const Params& p, const float* cw) {
    const int ch = h * 64 + l16 * 4;
    P.ka = *(const f32x4*)(p.in[I_KA] + ch); P.rk = *(const f32x4*)(p.in[I_RK] + ch); P.gg = *(const f32x4*)(p.in[I_GNG] + ch); P.gb = *(const f32x4*)(p.in[I_GNB] + ch);
#pragma unroll
    for (int w = 0; w < 3; ++w)
#pragma unroll
        for (int t = 0; t < 3; ++t) P.c[w][t] = *(const f32x4*)(cw + t * RW_COLS + w * 1024 + ch);
}
__device__ __forceinline__ void comb_compute(const CombIn& q, int task, int l16, const CombPar& P, bf16_t* O) {
    const int row = task >> 4, h = task & 15, ch = h * 64 + l16 * 4;
    const f32x4 ka = P.ka, rk = P.rk, gg = P.gg, gb = P.gb;
    f32x4 rkv[3];
#pragma unroll
    for (int w = 0; w < 3; ++w) {
        const f32x4 c0 = P.c[w][0], c1 = P.c[w][1], c2 = P.c[w][2];
#pragma unroll
        for (int i = 0; i < 4; ++i) {
            const float a = (i & 1) ? __uint_as_float(q.pw[w][0][i >> 1] & 0xffff0000u) : __uint_as_float(q.pw[w][0][i >> 1] << 16);
            const float b = (i & 1) ? __uint_as_float(q.pw[w][1][i >> 1] & 0xffff0000u) : __uint_as_float(q.pw[w][1][i >> 1] << 16);
            const float c = (i & 1) ? __uint_as_float(q.pw[w][2][i >> 1] & 0xffff0000u) : __uint_as_float(q.pw[w][2][i >> 1] << 16);
            rkv[w][i] = c0[i] * a + c1[i] * b + c2[i] * c;
        }
    }
    float bsum = 0.f, s0 = 0.f, s1 = 0.f;
    float gtv[4];
#pragma unroll
    for (int i = 0; i < 4; ++i) {
        const unsigned short ha = (unsigned short)((i & 1) ? (q.afw[i >> 1] >> 16) : (q.afw[i >> 1] & 0xffffu)), hb = (unsigned short)((i & 1) ? (q.abw[i >> 1] >> 16) : (q.abw[i >> 1] & 0xffffu)),
                             hg = (unsigned short)((i & 1) ? (q.gtw[i >> 1] >> 16) : (q.gtw[i >> 1] & 0xffffu));
        const float afv = (float)__builtin_bit_cast(h16, ha), abv = (float)__builtin_bit_cast(h16, hb); gtv[i] = (float)__builtin_bit_cast(h16, hg);
        const float khf = rkv[1][i] * (1.0f + (afv - 1.0f) * ka[i]), khb = rkv[1][i] * (1.0f + (abv - 1.0f) * ka[i]);
        bsum += rkv[0][i] * (khf + khb) * rk[i];
        s0 += q.y0[i]; s1 += q.y1[i];
    }
    bsum = sum16(bsum); s0 = sum16(s0) * (1.0f / 64.0f); s1 = sum16(s1) * (1.0f / 64.0f);
    float q0 = 0.f, q1 = 0.f;
    const f32x4 d0 = q.y0 - s0, d1 = q.y1 - s1;
#pragma unroll
    for (int i = 0; i < 4; ++i) { q0 += d0[i] * d0[i]; q1 += d1[i] * d1[i]; }
    const float r0 = __builtin_amdgcn_rsqf(sum16(q0) * (1.0f / 64.0f) + GN_EPS), r1 = __builtin_amdgcn_rsqf(sum16(q1) * (1.0f / 64.0f) + GN_EPS);
    float o[4];
#pragma unroll
    for (int i = 0; i < 4; ++i) o[i] = ((d0[i] * r0 + d1[i] * r1) * gg[i] + 2.0f * gb[i] + bsum * rkv[2][i]) * gtv[i];
    u32x2 w2; w2.x = cvt_pk_bf16(o[0], o[1]); w2.y = cvt_pk_bf16(o[2], o[3]);
    *(u32x2*)(O + (size_t)row * D + ch) = w2;
}

__device__ __forceinline__ void phase_combine(const Params& p, LAS unsigned char* lds) {
    const int tid = threadIdx.x, G = gridDim.x, bid = blockIdx.x, lane = tid & 63, wv = tid >> 6;
    const bf16_t* proj = (const bf16_t*)(p.ws + OFF_R5);
    const h16* lora = (const h16*)(p.ws + OFF_R6);
    const h16* af = lora + 2 * LORA_STRIDE; const h16* ab = lora + 3 * LORA_STRIDE; const h16* gate = lora + 4 * LORA_STRIDE;
    bf16_t* O = (bf16_t*)(p.ws + OFF_R6);
    const float* yf = p.out; const float* yb = p.out + (size_t)NTOK * 1024;
    const float* cw = p.in[I_CONVRW];
    {
        const int sub = lane >> 4, l16 = lane & 15;
        const int tstride = G * 32;
        CombPar par; comb_params(par, ((bid * 8 + wv) * 4 + sub) & 15, l16, p, cw);
        for (int task0 = (bid * 8 + wv) * 4 + sub; task0 < NTOK * 16; task0 += 2 * tstride) {
            CombIn in[2];
#pragma unroll
            for (int u = 0; u < 2; ++u) { const int task = task0 + u * tstride < NTOK * 16 ? task0 + u * tstride : task0; comb_load(in[u], task, l16, proj, af, ab, gate, yf, yb); }
#pragma unroll
            for (int u = 0; u < 2; ++u) {
                const int task = task0 + u * tstride;
                if (task < NTOK * 16) comb_compute(in[u], task, l16, par, O);
            }
        }
    }
    LAS float* tile = (LAS float*)lds;
    const bf16_t* yT = (const bf16_t*)(p.ws + OFF_R4);
    {
        const int cl = tid >> 3, ts = (tid & 7) * 8, tl = tid >> 3, cs = (tid & 7) * 8;
        u32x4 yw, nyw; u32x4 rx[3], nx[3];
        HyW W0; int ctw = -1;
        if (bid < 4096) { const int ct = bid & 15, tt = (bid >> 4) & 63, b = bid >> 10;
            yw = *(const u32x4*)(yT + ((size_t)(b * 1024 + ct * 64 + cl)) * SEQ + tt * 64 + ts);
            const int t = tt * 64 + tl; hy_raw3(proj + (size_t)(b * SEQ + t) * NP + RWP + ct * 64 + cs, t > 0, t < SEQ - 1, rx); }
        for (int u = bid; u < 4096; u += G) {
            const int ct = u & 15, tt = (u >> 4) & 63, b = u >> 10;
            { const int un = u + G < 4096 ? u + G : u; const int nct = un & 15, ntt = (un >> 4) & 63, nb = un >> 10;
              nyw = *(const u32x4*)(yT + ((size_t)(nb * 1024 + nct * 64 + cl)) * SEQ + ntt * 64 + ts);
              const int t = ntt * 64 + tl; hy_raw3(proj + (size_t)(nb * SEQ + t) * NP + RWP + nct * 64 + cs, t > 0, t < SEQ - 1, nx); }
            __syncthreads();
#pragma unroll
            for (int i = 0; i < 4; ++i) { tile[cl * 65 + ts + 2 * i] = __uint_as_float(yw[i] << 16); tile[cl * 65 + ts + 2 * i + 1] = __uint_as_float(yw[i] & 0xffff0000u); }
            __syncthreads();
            const int t = tt * 64 + tl, row = b * SEQ + t, c = ct * 64 + cs;
            float x0[8];
            if (ct != ctw) { hy_wload(W0, p.in[I_CONVHY], p.in[I_CONVHYB], 3072, c); ctw = ct; }
            hy_convw(rx, W0, x0);
            float o[8];
#pragma unroll
            for (int i = 0; i < 8; ++i) o[i] = tile[(cs + i) * 65 + tl] * x0[i];
            u32x4 w; w.x = cvt_pk_bf16(o[0], o[1]); w.y = cvt_pk_bf16(o[2], o[3]); w.z = cvt_pk_bf16(o[4], o[5]); w.w = cvt_pk_bf16(o[6], o[7]);
            *(u32x4*)(O + (size_t)row * D + 1024 + c) = w;
            yw = nyw;
#pragma unroll
            for (int i = 0; i < 3; ++i) rx[i] = nx[i];
        }
    }
}

__device__ __forceinline__ void phase_ffn_weights(const Params& p, LAS unsigned char* lds) {
    LAS float* tile = (LAS float*)lds;
    bf16_t* W13T = (bf16_t*)(p.ws + OFF_R5); bf16_t* W2T = (bf16_t*)(p.ws + OFF_R5 + 44 * MBy);
    const int n13 = 32 * 22, n2 = 88 * 8;
    for (int u = blockIdx.x; u < 2 * n13 + n2; u += gridDim.x) {
        if (u < n13) tr_tile(tile, p.in[I_FFW1], DFF, (u & 31) * 64, (u >> 5) * TRN, W13T, D, MapFF{0});
        else if (u < 2 * n13) { const int v = u - n13; tr_tile(tile, p.in[I_FFW3], DFF, (v & 31) * 64, (v >> 5) * TRN, W13T, D, MapFF{128}); }
        else { const int v = u - 2 * n13; tr_tile(tile, p.in[I_FFW2], D, (v % 88) * 64, (v / 88) * TRN, W2T, DFF, MapId()); }
    }
    __syncthreads();
}

template <int MODE> struct LnRow;
template <> struct LnRow<0> { f32x4 r[8]; u32x2 s[8]; };
template <> struct LnRow<1> { u32x2 r[8]; u32x2 s[8]; };
__device__ __forceinline__ f32x4 bf4(u32x2 w) { return (f32x4){__uint_as_float(w.x << 16), __uint_as_float(w.x & 0xffff0000u), __uint_as_float(w.y << 16), __uint_as_float(w.y & 0xffff0000u)}; }
__device__ __forceinline__ void ln_load(LnRow<0>& q, const void* resid, const bf16_t* small, int row, int lane) {
#pragma unroll
    for (int i = 0; i < 8; ++i) { q.r[i] = *(const f32x4*)((const float*)resid + (size_t)row * D + i * 256 + lane * 4); q.s[i] = *(const u32x2*)(small + (size_t)row * D + i * 256 + lane * 4); }
}
__device__ __forceinline__ void ln_load(LnRow<1>& q, const void* resid, const bf16_t* small, int row, int lane) {
#pragma unroll
    for (int i = 0; i < 8; ++i) { q.r[i] = *(const u32x2*)((const bf16_t*)resid + (size_t)row * D + i * 256 + lane * 4); q.s[i] = *(const u32x2*)(small + (size_t)row * D + i * 256 + lane * 4); }
}
__device__ __forceinline__ f32x4 ln_resid(const LnRow<0>& q, int i) { return q.r[i]; }
__device__ __forceinline__ f32x4 ln_resid(const LnRow<1>& q, int i) { return bf4(q.r[i]); }
template <int MODE>
__device__ __forceinline__ void phase_ln(const Params& p, LAS unsigned char* lds, const void* resid, const bf16_t* small, int gate_idx, float* dst, bf16_t* X1, bf16_t* U, const float* g, const float* bta) {
    const int lane = threadIdx.x & 63, wv = threadIdx.x >> 6;
    const float* mod = (const float*)(p.ws + OFF_MOD); const float* pe = (const float*)(p.ws + OFF_PE);
    LAS float* PL = (LAS float*)lds;
    constexpr int NPB = MODE == 0 ? 3 : 1, NARR = 2 + 4 * NPB;
    __syncthreads();
    for (int i = threadIdx.x; i < NARR * (D / 4); i += NTHREADS) {
        const int arr = i >> 9, c = (i & 511) * 4;
        const float* srcp = arr == 0 ? g + c : arr == 1 ? bta + c : mod + (size_t)((arr - 2) / NPB) * 6 * D + (MODE == 0 ? 2 + (arr - 2) % NPB : gate_idx) * D + c;
        *(LAS f32x4*)(PL + arr * D + c) = *(const f32x4*)srcp;
    }
    __syncthreads();
    const int stride = gridDim.x * 8;
    int row = blockIdx.x * 8 + wv;
    LnRow<MODE> cur, nxt;
    if (row < NTOK) ln_load(cur, resid, small, row, lane);
    for (; row < NTOK; row += stride) {
        const int rn = row + stride < NTOK ? row + stride : row;
        ln_load(nxt, resid, small, rn, lane);
        const int b = row >> 12, t = row & 4095;
        f32x4 v[8];
        float s = 0.f;
#pragma unroll
        for (int i = 0; i < 8; ++i) { const int c = i * 256 + lane * 4;
            f32x4 rs = ln_resid(cur, i);
            if (MODE == 0) { const float* pp = c < 1024 ? pe + (t >> 6) * 1024 + c : pe + (t & 63) * 1024 + (c - 1024); rs += *(const f32x4*)pp; }
            const f32x4 gv = *(const LAS f32x4*)(PL + (2 + b * NPB) * D + c);
            v[i] = rs * ALPHA + gv * bf4(cur.s[i]);
            s += (v[i][0] + v[i][1]) + (v[i][2] + v[i][3]); }
        const float mu = wave_sum(s) * (1.0f / D);
        float q = 0.f;
#pragma unroll
        for (int i = 0; i < 8; ++i) { v[i] -= mu; q += (v[i][0] * v[i][0] + v[i][1] * v[i][1]) + (v[i][2] * v[i][2] + v[i][3] * v[i][3]); }
        const float rs_ = __builtin_amdgcn_rsqf(wave_sum(q) * (1.0f / D) + LN_EPS);
#pragma unroll
        for (int i = 0; i < 8; ++i) { const int c = i * 256 + lane * 4;
            const f32x4 o = v[i] * rs_ * *(const LAS f32x4*)(PL + c) + *(const LAS f32x4*)(PL + D + c);
            if (MODE == 1) *(f32x4*)(dst + (size_t)row * D + c) = o;
            if (MODE == 0) { u32x2 xw; xw.x = cvt_pk_bf16(o[0], o[1]); xw.y = cvt_pk_bf16(o[2], o[3]); *(u32x2*)(X1 + (size_t)row * D + c) = xw;
                const f32x4 sh = *(const LAS f32x4*)(PL + (2 + b * NPB + 1) * D + c), sc = *(const LAS f32x4*)(PL + (2 + b * NPB + 2) * D + c);
                const f32x4 m = o * (sc + 1.0f) + sh; u32x2 w; w.x = cvt_pk_bf16(m[0], m[1]); w.y = cvt_pk_bf16(m[2], m[3]); *(u32x2*)(U + (size_t)row * D + c) = w; } }
        cur = nxt;
    }
}

constexpr int N_PHASES = 13;
#ifndef SYNC_REPS
#define SYNC_REPS 1
#endif
#ifndef DUP_MASK
#define DUP_MASK 0
#endif
#define gsync() do { XcdBarrier _gb; _gb.bar = (unsigned*)(p.ws + OFF_BAR); _gb.x = xb_xcc_id(); _gb.st = (volatile LAS unsigned*)(lds + 131072); for (int _r = 0; _r < SYNC_REPS; ++_r) xcd_barrier(_gb); } while (0)
#ifndef ONLY_PHASE
#define PH_ON(n) true
#else
#define PH_ON(n) ((n) == ONLY_PHASE)
#endif
__global__ void __launch_bounds__(NTHREADS) fwd_mega(Params p) {
    extern __shared__ __attribute__((aligned(16))) unsigned char lds_raw[];
    LAS unsigned char* lds = (LAS unsigned char*)lds_raw;
    unsigned char* ws = p.ws;
    const int G = gridDim.x;
    volatile LAS unsigned* bst = (volatile LAS unsigned*)(lds + 131072);
    if (threadIdx.x < 4) bst[threadIdx.x] = 0u;
    __syncthreads();
    (void)xcd_barrier_post((unsigned*)(ws + OFF_BAR), bst);
    if (p.ph_hi > 1000) cg::this_grid().sync();
    if (PH_ON(0) && p.ph_lo <= 0 && 0 < p.ph_hi) { if (0 > p.ph_lo) gsync();
      for (int rep = 0; rep < (((DUP_MASK >> 0) & 1) ? 2 : 1); ++rep) { if (rep) gsync();
        phase_prep(p, lds);
      }
    }
    if (PH_ON(1) && p.ph_lo <= 1 && 1 < p.ph_hi) { if (1 > p.ph_lo) gsync();
      for (int rep = 0; rep < (((DUP_MASK >> 1) & 1) ? 2 : 1); ++rep) { if (rep) gsync();
        phase_modfin(p);
      }
    }
    if (PH_ON(2) && p.ph_lo <= 2 && 2 < p.ph_hi) { if (2 > p.ph_lo) gsync();
      for (int rep = 0; rep < (((DUP_MASK >> 2) & 1) ? 2 : 1); ++rep) { if (rep) gsync();
        phase_a1(p);
      }
    }
    if (PH_ON(3) && p.ph_lo <= 3 && 3 < p.ph_hi) { if (3 > p.ph_lo) gsync();
      for (int rep = 0; rep < (((DUP_MASK >> 3) & 1) ? 2 : 1); ++rep) { if (rep) gsync();
        {
                  { pg8::Gemm g{(const bf16_t*)(ws + OFF_R4), (const bf16_t*)(ws + OFF_R1), NTOK, NP, D}; pg8::StaticOrder S; S.init(NTOK, NP, G, blockIdx.x);
                    EpiProj E{(bf16_t*)(ws + OFF_R5), NP}; pg8::gemm_phase(lds, g, S, E); }
                  { pg8::Gemm g{(const bf16_t*)(ws + OFF_R4) + (size_t)NTOK * D, (const bf16_t*)(ws + OFF_R1), NCTX, RWP, D}; pg8::StaticOrder S; S.init(NCTX, RWP, G, (blockIdx.x + G / 2) % G);
                    EpiProj E{(bf16_t*)(ws + OFF_R5) + (size_t)NTOK * NP, NP}; pg8::gemm_phase(lds, g, S, E); } }
      }
    }
    if (PH_ON(4) && p.ph_lo <= 4 && 4 < p.ph_hi) { if (4 > p.ph_lo) gsync();
      for (int rep = 0; rep < (((DUP_MASK >> 4) & 1) ? 2 : 1); ++rep) { if (rep) gsync();
        phase_post_proj(p, lds);
      }
    }
    if (PH_ON(5) && p.ph_lo <= 5 && 5 < p.ph_hi) { if (5 > p.ph_lo) gsync();
      for (int rep = 0; rep < (((DUP_MASK >> 5) & 1) ? 2 : 1); ++rep) { if (rep) gsync();
        { pg8::Gemm g{(const bf16_t*)(ws + OFF_R1), (const bf16_t*)(ws + OFF_BT2), MROWS, NL, KL + (p.ph_hi >> 20) * 128}; pg8::StaticOrder S; S.init(MROWS, NL, G, blockIdx.x);
                  EpiLora E{(h16*)(ws + OFF_R6), (const float*)(ws + OFF_LB)};
#ifndef NO_LGEMM
                  pg8::gemm_phase(lds, g, S, E);
#endif

#ifndef NO_FFT
                  phase_hyena_fft(p, lds);
#endif
                  }
      }
    }
    if (PH_ON(6) && p.ph_lo <= 6 && 6 < p.ph_hi) { if (6 > p.ph_lo) gsync();
      for (int rep = 0; rep < (((DUP_MASK >> 6) & 1) ? 2 : 1); ++rep) { if (rep) gsync();
        phase_scan(p, lds);
      }
    }
    if (PH_ON(7) && p.ph_lo <= 7 && 7 < p.ph_hi) { if (7 > p.ph_lo) gsync();
      for (int rep = 0; rep < (((DUP_MASK >> 7) & 1) ? 2 : 1); ++rep) { if (rep) gsync();
        phase_combine(p, lds);
      }
    }
    if (PH_ON(8) && p.ph_lo <= 8 && 8 < p.ph_hi) { if (8 > p.ph_lo) gsync();
      for (int rep = 0; rep < (((DUP_MASK >> 8) & 1) ? 2 : 1); ++rep) { if (rep) gsync();
        {
                  pg8::Gemm g{(const bf16_t*)(ws + OFF_R6), (const bf16_t*)(ws + OFF_WOUT), NTOK, D, D}; pg8::StaticOrder S; S.init(NTOK, D, G, blockIdx.x);
                  EpiProj E{(bf16_t*)p.out, D}; pg8::gemm_phase(lds, g, S, E); }
      }
    }
    if (PH_ON(9) && p.ph_lo <= 9 && 9 < p.ph_hi) { if (9 > p.ph_lo) gsync();
      for (int rep = 0; rep < (((DUP_MASK >> 9) & 1) ? 2 : 1); ++rep) { if (rep) gsync();
        { phase_ln<0>(p, lds, p.in[I_X], (const bf16_t*)p.out, 2, nullptr, (bf16_t*)(ws + OFF_R5 + 66 * MBy), (bf16_t*)(ws + OFF_R4), p.in[I_LN1G], p.in[I_LN1B]); phase_ffn_weights(p, lds); }
      }
    }
    if (PH_ON(10) && p.ph_lo <= 10 && 10 < p.ph_hi) { if (10 > p.ph_lo) gsync();
      for (int rep = 0; rep < (((DUP_MASK >> 10) & 1) ? 2 : 1); ++rep) { if (rep) gsync();
        { pg8::Gemm g{(const bf16_t*)(ws + OFF_R4), (const bf16_t*)(ws + OFF_R5), NTOK, 2 * DFF, D}; pg8::StaticOrder S; S.init(NTOK, 2 * DFF, G, blockIdx.x);
                   EpiSwiglu E{(bf16_t*)(ws + OFF_R1)}; pg8::gemm_phase(lds, g, S, E); }
      }
    }
    if (PH_ON(11) && p.ph_lo <= 11 && 11 < p.ph_hi) { if (11 > p.ph_lo) gsync();
      for (int rep = 0; rep < (((DUP_MASK >> 11) & 1) ? 2 : 1); ++rep) { if (rep) gsync();
        { pg8::Gemm g{(const bf16_t*)(ws + OFF_R1), (const bf16_t*)(ws + OFF_R5 + 44 * MBy), NTOK, D, DFF}; pg8::StaticOrder S; S.init(NTOK, D, G, blockIdx.x);
                   EpiProj E{(bf16_t*)(ws + OFF_R4), D}; pg8::gemm_phase(lds, g, S, E); }
      }
    }
    if (PH_ON(12) && p.ph_lo <= 12 && 12 < p.ph_hi) { if (12 > p.ph_lo) gsync();
      for (int rep = 0; rep < (((DUP_MASK >> 12) & 1) ? 2 : 1); ++rep) { if (rep) gsync();
        phase_ln<1>(p, lds, (const void*)(ws + OFF_R5 + 66 * MBy), (const bf16_t*)(ws + OFF_R4), 5, p.out, nullptr, nullptr, p.in[I_LN2G], p.in[I_LN2B]);
      }
    }
}

#ifndef N_LAUNCH_SPLIT
#define N_LAUNCH_SPLIT 1
#endif
extern "C" void kernel_launch(void* const* d_in, const int* in_sizes, int n_in, void* d_out, int out_size, void* d_ws, size_t ws_size, hipStream_t stream) {
    static int grid = 0;
    if (grid == 0) {
        if (n_in != 39 || ws_size < WS_END || out_size != NTOK * D) { fprintf(stderr, "kernel_launch: unexpected shapes (n_in %d, ws %zu, out %d)\n", n_in, ws_size, out_size); grid = -1; return; }
        int dev = 0, cus = 0, per_cu = 0;
        hipGetDevice(&dev); hipDeviceGetAttribute(&cus, hipDeviceAttributeMultiprocessorCount, dev);
        if (hipFuncSetAttribute((const void*)fwd_mega, hipFuncAttributeMaxDynamicSharedMemorySize, LDS_BYTES) != hipSuccess) { fprintf(stderr, "kernel_launch: hipFuncSetAttribute failed\n"); grid = -1; return; }
        if (hipOccupancyMaxActiveBlocksPerMultiprocessor(&per_cu, (const void*)fwd_mega, NTHREADS, LDS_BYTES) != hipSuccess || per_cu < 1) { fprintf(stderr, "kernel_launch: occupancy query gives %d\n", per_cu); per_cu = 1; }
        (void)hipGetLastError();
        grid = cus * 1;
        if (grid <= 0) grid = 256;
    }
    if (grid < 0) return;
    if (hipMemsetAsync((char*)d_ws + OFF_BAR, 0, XCD_BAR_WORDS * 4, stream) != hipSuccess) { fprintf(stderr, "kernel_launch: memset of barrier words failed\n"); return; }
    Params p{};
    for (int i = 0; i < 39; ++i) p.in[i] = (const float*)d_in[i];
    p.out = (float*)d_out; p.ws = (unsigned char*)d_ws;
#if N_LAUNCH_SPLIT
    p.ph_lo = 0; p.ph_hi = N_PHASES;
    void* args[] = {&p};
    hipError_t e = hipLaunchCooperativeKernel((const void*)fwd_mega, dim3(grid), dim3(NTHREADS), args, LDS_BYTES, stream);
    if (e != hipSuccess) fprintf(stderr, "cooperative launch failed: %s (grid %d)\n", hipGetErrorString(e), grid);
#else
    for (int ph = 0; ph < N_PHASES; ++ph) { p.ph_lo = ph; p.ph_hi = ph + 1; hipLaunchKernelGGL(fwd_mega, dim3(grid), dim3(NTHREADS), LDS_BYTES, stream, p); }
#endif
}
```
